# Optimizing an MI355X kernel written in HIP

```python
import math
import jax
import jax.numpy as jnp
from jax import lax
import numpy as np

D_MODEL = 2048
BATCH = 16
SEQ = 2048
DEPTH = 4

GRID_W = 64
CTX_LEN = 256
N_MIXERS = 3
N_MOD = 6
RMS_EPS = 1e-6

HG_DK = 128
HG_HEADS = D_MODEL // HG_DK
HG_WIDTH = HG_HEADS * HG_DK
HG_CHUNK = 16

GDN_DK = 128
GDN_DV = 128
GDN_QK_HEADS = D_MODEL // GDN_DK
GDN_V_HEADS = 2 * GDN_QK_HEADS
GDN_QK_WIDTH = GDN_QK_HEADS * GDN_DK
GDN_V_WIDTH = GDN_V_HEADS * GDN_DV
GDN_CONV_DIM = 2 * GDN_QK_WIDTH + GDN_V_WIDTH
GDN_IN_WIDTH = GDN_CONV_DIM + GDN_V_WIDTH + 4 * GDN_V_HEADS
GDN_CONV = 5
GDN_CHUNK = 64

NA_HEAD_DIM = 32
NA_HEADS = D_MODEL // NA_HEAD_DIM
NA_WIN_R = 8
NA_WIN_C = 16
NA_QB = 16
NA_KB = NA_QB + NA_WIN_C

D_FF = ((8 * D_MODEL // 3 + 127) // 128) * 128
FFN_CONV = 3

kernel_name = 'hybrid_flow_backbone_hgrn2_gdn_natten'


def _n_layers_of(m):
    return (DEPTH - m + N_MIXERS - 1) // N_MIXERS


def rmsnorm(x, g):
    xf = x.astype(jnp.float32)
    y = xf * lax.rsqrt(jnp.mean(xf * xf, axis=-1, keepdims=True) + RMS_EPS)
    return (y * g.astype(jnp.float32)).astype(x.dtype)


def l2norm(x):
    return x * lax.rsqrt(jnp.sum(x * x, axis=-1, keepdims=True) + RMS_EPS)


def modulate(x, g, shift, scale):
    return rmsnorm(x, g) * (1.0 + scale) + shift


def dwconv_centred(u, w):
    K, T = w.shape[0], u.shape[1]
    pad = K // 2
    up = jnp.pad(u, ((0, 0), (pad, pad), (0, 0)))
    out = up[:, 0:T] * w[0]
    for j in range(1, K):
        out = out + up[:, j:j + T] * w[j]
    return out


def _rev(a):
    return jnp.flip(a, axis=1)


def _ident(a):
    return a


def _to_chunks(a, size):
    B, T = a.shape[:2]
    return jnp.moveaxis(a.reshape(B, T // size, size, *a.shape[2:]), 1, 0)


def _from_chunks(a):
    a = jnp.moveaxis(a, 0, 1)
    return a.reshape(a.shape[0], a.shape[1] * a.shape[2], *a.shape[3:])


def conv_ffn(h, w_up, conv_w, w_down):
    u = dwconv_centred(h @ w_up, conv_w)
    a, b = jnp.split(u, 2, axis=-1)
    return (jax.nn.silu(a) * b) @ w_down


def hgrn2_lower_bound(lb_logits, j):
    cs = jnp.cumsum(jax.nn.softmax(lb_logits.astype(jnp.float32), axis=0), axis=0)
    return cs[j] - cs[0]


def hgrn2_scan(q, k, v, logf, s0, need_out):
    tri = jnp.asarray(np.tril(np.ones((HG_CHUNK, HG_CHUNK), bool)))[None, :, :, None, None]

    def step(S, xs):
        qc, kc, vc, gc = xs
        b = jnp.cumsum(gc, axis=1)
        b_end = b[:, -1]
        S_new = jnp.exp(b_end)[..., None] * S + jnp.einsum('bshk,bshv->bhkv', kc * jnp.exp(b_end[:, None] - b), vc)
        if not need_out:
            return S_new, None
        dec = jnp.exp(jnp.where(tri, b[:, :, None] - b[:, None, :], -jnp.inf))
        att = jnp.einsum('bthk,bshk,btshk->bhts', qc, kc, dec)
        o = jnp.einsum('bthk,bhkv->bthv', qc * jnp.exp(b), S) + jnp.einsum('bhts,bshv->bthv', att, vc)
        return S_new, o

    xs = tuple(_to_chunks(a, HG_CHUNK) for a in (q, k, v, logf))
    S, o = lax.scan(step, s0, xs)
    return (_from_chunks(o) if need_out else None), S


def hgrn2_mixer(h, h_c, w_in, lb, norm_g, w_out, need_ctx_out):
    lbh = lb.reshape(2, HG_HEADS, HG_DK)
    log_lb, log_1m_lb = jnp.log(lbh), jnp.log1p(-lbh)

    def project(u):
        B, T, _ = u.shape
        p = (u @ w_in).astype(jnp.float32).reshape(B, T, 5, HG_HEADS, HG_DK)
        q, inp, gate = jax.nn.silu(p[:, :, 0]), p[:, :, 1], p[:, :, 4]
        keys = [(1.0 - lbh[d]) * jax.nn.sigmoid(-p[:, :, 2 + d]) for d in range(2)]
        logf = [jnp.logaddexp(log_lb[d], log_1m_lb[d] + jax.nn.log_sigmoid(p[:, :, 2 + d])) for d in range(2)]
        return q, inp, keys, logf, gate

    def readout(o, gate):
        B, T = o.shape[:2]
        y = rmsnorm(o, norm_g) * jax.nn.silu(gate)
        return y.reshape(B, T, HG_WIDTH).astype(h.dtype) @ w_out

    q_c, i_c, k_c, f_c, g_c = project(h_c)
    q, i, k, f, g = project(h)
    s0 = jnp.zeros((h.shape[0], HG_HEADS, HG_DK, HG_DK), jnp.float32)
    o, o_c = 0.0, 0.0
    for d in range(2):
        rev = _rev if d == 1 else _ident
        oc_d, s_ctx = hgrn2_scan(rev(q_c), rev(k_c[d]), rev(i_c), rev(f_c[d]), s0, need_ctx_out)
        ol_d, _ = hgrn2_scan(rev(q), rev(k[d]), rev(i), rev(f[d]), s_ctx, True)
        o = o + rev(ol_d)
        if need_ctx_out:
            o_c = o_c + rev(oc_d)
    y_c = readout(o_c, g_c) if need_ctx_out else None
    return readout(o, g), y_c


def gdn_scan(q, k, v, g, beta, s0, need_out):
    B, T, H, _ = k.shape
    C = GDN_CHUNK

    def chunks(a):
        return jnp.moveaxis(_to_chunks(a, C), 3, 2)

    q_c, k_c, v_c, g_c, b_c = (chunks(a) for a in (q, k, v, g, beta))
    g_c = jnp.cumsum(g_c, axis=-1)
    diff = g_c[..., :, None] - g_c[..., None, :]
    strict = np.tril(np.ones((C, C), bool), -1)
    incl = np.tril(np.ones((C, C), bool))
    k_beta = k_c * b_c[..., None]
    lmat = jnp.einsum('nbhtk,nbhsk->nbhts', k_beta, k_c) * jnp.exp(jnp.where(strict, diff, -jnp.inf))
    rhs = jnp.concatenate([v_c * b_c[..., None], k_beta * jnp.exp(g_c)[..., None]], axis=-1)
    sol = lax.linalg.triangular_solve(lmat + jnp.eye(C, dtype=lmat.dtype), rhs,
                                      left_side=True, lower=True, unit_diagonal=True)
    u, w = sol[..., :GDN_DV], sol[..., GDN_DV:]
    g_end = g_c[..., -1]
    k_dec = k_c * jnp.exp(g_end[..., None] - g_c)[..., None]
    xs = (u, w, k_dec, g_end)
    if need_out:
        qk = jnp.einsum('nbhtk,nbhsk->nbhts', q_c, k_c) * jnp.exp(jnp.where(incl, diff, -jnp.inf))
        xs = xs + (q_c * jnp.exp(g_c)[..., None], qk)

    def step(S, xs_i):
        u_i, w_i, kd_i, ge_i = xs_i[:4]
        v_new = u_i - jnp.einsum('bhck,bhkv->bhcv', w_i, S)
        S_new = S * jnp.exp(ge_i)[..., None, None] + jnp.einsum('bhck,bhcv->bhkv', kd_i, v_new)
        if not need_out:
            return S_new, None
        qd_i, qk_i = xs_i[4:]
        o = jnp.einsum('bhck,bhkv->bhcv', qd_i, S) + jnp.einsum('bhts,bhsv->bhtv', qk_i, v_new)
        return S_new, o

    S, o = lax.scan(step, s0, xs)
    if need_out:
        o = jnp.transpose(o, (1, 0, 3, 2, 4)).reshape(B, T, H, GDN_DV)
    return o, S


def gdn_mixer(h, h_c, w_in, conv_w, a_log, dt_bias, norm_g, w_out, need_ctx_out):
    rep = GDN_V_HEADS // GDN_QK_HEADS
    decay_rate = jnp.exp(a_log.astype(jnp.float32))
    dtb = dt_bias.astype(jnp.float32)

    def project(u):
        B, T, _ = u.shape
        p = u @ w_in
        qkv = jax.nn.silu(dwconv_centred(p[..., :GDN_CONV_DIM], conv_w)).astype(jnp.float32)
        q = l2norm(qkv[..., :GDN_QK_WIDTH].reshape(B, T, GDN_QK_HEADS, GDN_DK))
        k = l2norm(qkv[..., GDN_QK_WIDTH:2 * GDN_QK_WIDTH].reshape(B, T, GDN_QK_HEADS, GDN_DK))
        v = qkv[..., 2 * GDN_QK_WIDTH:].reshape(B, T, GDN_V_HEADS, GDN_DV)
        q = jnp.repeat(q, rep, axis=2) * (GDN_DK ** -0.5)
        k = jnp.repeat(k, rep, axis=2)
        z = p[..., GDN_CONV_DIM:GDN_CONV_DIM + GDN_V_WIDTH].astype(jnp.float32).reshape(B, T, GDN_V_HEADS, GDN_DV)
        ba = p[..., GDN_CONV_DIM + GDN_V_WIDTH:].astype(jnp.float32).reshape(B, T, 2, 2, GDN_V_HEADS)
        beta = jax.nn.sigmoid(ba[:, :, :, 0])
        g = -decay_rate * jax.nn.softplus(ba[:, :, :, 1] + dtb)
        return q, k, v, z, beta, g

    def readout(o, z):
        B, T = o.shape[:2]
        y = rmsnorm(o, norm_g) * jax.nn.silu(z)
        return y.reshape(B, T, GDN_V_WIDTH).astype(h.dtype) @ w_out

    q_c, k_c, v_c, z_c, b_c, g_c = project(h_c)
    q, k, v, z, b, g = project(h)
    s0 = jnp.zeros((h.shape[0], GDN_V_HEADS, GDN_DK, GDN_DV), jnp.float32)
    o, o_c = 0.0, 0.0
    for d in range(2):
        rev = _rev if d == 1 else _ident
        oc_d, s_ctx = gdn_scan(rev(q_c), rev(k_c), rev(v_c), rev(g_c[:, :, d]), rev(b_c[:, :, d]), s0, need_ctx_out)
        ol_d, _ = gdn_scan(rev(q), rev(k), rev(v), rev(g[:, :, d]), rev(b[:, :, d]), s_ctx, True)
        o = o + rev(ol_d)
        if need_ctx_out:
            o_c = o_c + rev(oc_d)
    y_c = readout(o_c, z_c) if need_ctx_out else None
    return readout(o, z), y_c


def _na_column_tables():
    nb = GRID_W // NA_QB
    cols = np.arange(GRID_W)
    c0 = np.clip(cols - NA_WIN_C // 2, 0, GRID_W - NA_WIN_C).reshape(nb, NA_QB)
    qcol = cols.reshape(nb, NA_QB)
    kc0 = np.clip(np.arange(nb) * NA_QB - NA_WIN_C // 2, 0, GRID_W - NA_KB)
    kcol = kc0[:, None] + np.arange(NA_KB)
    mask = (kcol[:, None, :] >= c0[:, :, None]) & (kcol[:, None, :] < c0[:, :, None] + NA_WIN_C)
    dc_idx = np.clip(kcol[:, None, :] - qcol[:, :, None] + NA_WIN_C - 1, 0, 2 * NA_WIN_C - 2)
    return mask, dc_idx, [int(s) for s in kc0]


def na_mixer(h, h_c, w_qkv, q_norm_g, k_norm_g, rpb, w_out, need_ctx_out):
    B, T, _ = h.shape
    rows = T // GRID_W
    kr = min(NA_WIN_R, rows)
    nb = GRID_W // NA_QB
    n_lat = kr * NA_KB
    scale = NA_HEAD_DIM ** -0.5

    def project(u):
        p = (u @ w_qkv).reshape(u.shape[0], u.shape[1], 3, NA_HEADS, NA_HEAD_DIM)
        q = rmsnorm(p[:, :, 0], q_norm_g)
        k = rmsnorm(p[:, :, 1], k_norm_g)
        return [jnp.swapaxes(a, 1, 2) for a in (q, k, p[:, :, 2])]

    def readout(o):
        return jnp.swapaxes(o, 1, 2).reshape(o.shape[0], o.shape[2], D_MODEL) @ w_out

    q_c, k_c, v_c = project(h_c)
    q, k, v = project(h)

    y_c = None
    if need_ctx_out:
        s = jnp.einsum('bhqd,bhkd->bhqk', q_c, k_c).astype(jnp.float32) * scale
        y_c = readout(jnp.einsum('bhqk,bhkd->bhqd', jax.nn.softmax(s, axis=-1).astype(v_c.dtype), v_c))

    col_mask_np, dc_idx, kc0 = _na_column_tables()
    col_mask = jnp.asarray(np.broadcast_to(col_mask_np[:, :, None, :], (nb, NA_QB, kr, NA_KB)).reshape(nb, NA_QB, n_lat))
    kg = k.reshape(B, NA_HEADS, rows, GRID_W, NA_HEAD_DIM)
    vg = v.reshape(B, NA_HEADS, rows, GRID_W, NA_HEAD_DIM)
    q_rows = jnp.moveaxis(q.reshape(B, NA_HEADS, rows, GRID_W, NA_HEAD_DIM), 2, 0)

    def row_block(args):
        r, q_r = args
        r0 = jnp.clip(r - kr // 2, 0, rows - kr)
        k_rows = lax.dynamic_slice_in_dim(kg, r0, kr, axis=2)
        v_rows = lax.dynamic_slice_in_dim(vg, r0, kr, axis=2)

        def gather_blocks(a):
            return jnp.stack([a[:, :, :, s:s + NA_KB] for s in kc0], axis=2).reshape(B, NA_HEADS, nb, n_lat, NA_HEAD_DIM)

        k_blk, v_blk = gather_blocks(k_rows), gather_blocks(v_rows)
        q_blk = q_r.reshape(B, NA_HEADS, nb, NA_QB, NA_HEAD_DIM)
        dr_idx = r0 + jnp.arange(kr) - r + (NA_WIN_R - 1)
        bias = jnp.take(rpb, dr_idx, axis=1)[:, :, dc_idx]
        bias = jnp.transpose(bias, (0, 2, 3, 1, 4)).reshape(NA_HEADS, nb, NA_QB, n_lat).astype(jnp.float32)
        s_lat = jnp.einsum('bhnqd,bhnkd->bhnqk', q_blk, k_blk).astype(jnp.float32) * scale + bias
        s_lat = jnp.where(col_mask, s_lat, -jnp.inf)
        s_ctx = jnp.einsum('bhnqd,bhkd->bhnqk', q_blk, k_c).astype(jnp.float32) * scale
        p = jax.nn.softmax(jnp.concatenate([s_lat, s_ctx], axis=-1), axis=-1).astype(v.dtype)
        o = (jnp.einsum('bhnqk,bhnkd->bhnqd', p[..., :n_lat], v_blk)
             + jnp.einsum('bhnqk,bhkd->bhnqd', p[..., n_lat:], v_c))
        return o.reshape(B, NA_HEADS, GRID_W, NA_HEAD_DIM)

    o = lax.map(row_block, (jnp.arange(rows), q_rows))
    o = jnp.transpose(o, (1, 2, 0, 3, 4)).reshape(B, NA_HEADS, T, NA_HEAD_DIM)
    return readout(o), y_c


def setup_inputs(seed: int = 0) -> dict:
    key = jax.random.key(seed)
    keys = iter(jax.random.split(key, 32))
    f32 = jnp.float32
    D = D_MODEL
    n_hg, n_gdn, n_na = _n_layers_of(0), _n_layers_of(1), _n_layers_of(2)

    def normal(shape, scale):
        return jax.random.normal(next(keys), shape, f32) * scale

    def gain(shape):
        return 1.0 + normal(shape, 0.05)

    dt = jnp.exp(jax.random.uniform(next(keys), (n_gdn, 2, GDN_V_HEADS), f32, math.log(1e-3), math.log(1e-1)))
    a_log = jnp.log(jax.random.uniform(next(keys), (n_gdn, 2, GDN_V_HEADS), f32, 1.0, 16.0))
    return {
        'x': normal((BATCH, SEQ, D), 1.0),
        'c': normal((BATCH, D), 1.0),
        'ctx': normal((BATCH, CTX_LEN, D), 1.0),
        'c_ctx': normal((D,), 1.0),
        'ada_w': normal((DEPTH, D, N_MOD * D), 0.5 * D ** -0.5),
        'ada_b': normal((DEPTH, N_MOD * D), 0.01),
        'norm_mix_g': gain((DEPTH, D)),
        'norm_ffn_g': gain((DEPTH, D)),
        'hg_w_in': normal((n_hg, D, 5 * HG_WIDTH), D ** -0.5),
        'hg_lb_logits': normal((n_hg, 2, HG_WIDTH), 0.5),
        'hg_norm_g': gain((n_hg, HG_DK)),
        'hg_w_out': normal((n_hg, HG_WIDTH, D), HG_WIDTH ** -0.5),
        'gdn_w_in': normal((n_gdn, D, GDN_IN_WIDTH), D ** -0.5),
        'gdn_conv_w': normal((n_gdn, GDN_CONV, GDN_CONV_DIM), GDN_CONV ** -0.5),
        'gdn_a_log': a_log,
        'gdn_dt_bias': dt + jnp.log(-jnp.expm1(-dt)),
        'gdn_norm_g': gain((n_gdn, GDN_DV)),
        'gdn_w_out': normal((n_gdn, GDN_V_WIDTH, D), GDN_V_WIDTH ** -0.5),
        'na_w_qkv': normal((n_na, D, 3 * D), D ** -0.5),
        'na_q_norm_g': gain((n_na, NA_HEAD_DIM)),
        'na_k_norm_g': gain((n_na, NA_HEAD_DIM)),
        'na_rpb': normal((n_na, NA_HEADS, 2 * NA_WIN_R - 1, 2 * NA_WIN_C - 1), 0.02),
        'na_w_out': normal((n_na, D, D), D ** -0.5),
        'ffn_w_up': normal((DEPTH, D, 2 * D_FF), D ** -0.5),
        'ffn_conv_w': normal((DEPTH, FFN_CONV, 2 * D_FF), FFN_CONV ** -0.5),
        'ffn_w_down': normal((DEPTH, D_FF, D), D_FF ** -0.5),
    }


def reference(x, c, ctx, c_ctx, ada_w, ada_b, norm_mix_g, norm_ffn_g,
              hg_w_in, hg_lb_logits, hg_norm_g, hg_w_out,
              gdn_w_in, gdn_conv_w, gdn_a_log, gdn_dt_bias, gdn_norm_g, gdn_w_out,
              na_w_qkv, na_q_norm_g, na_k_norm_g, na_rpb, na_w_out,
              ffn_w_up, ffn_conv_w, ffn_w_down):
    s_c = jax.nn.silu(c)
    s_cc = jax.nn.silu(c_ctx)
    for i in range(DEPTH):
        m, j = i % N_MIXERS, i // N_MIXERS
        ctx_next = i < DEPTH - 1
        sh_a, sc_a, g_a, sh_f, sc_f, g_f = jnp.split((s_c @ ada_w[i] + ada_b[i])[:, None, :], N_MOD, axis=-1)
        csh_a, csc_a, cg_a, csh_f, csc_f, cg_f = jnp.split(s_cc @ ada_w[i] + ada_b[i], N_MOD, axis=-1)
        h = modulate(x, norm_mix_g[i], sh_a, sc_a)
        h_c = modulate(ctx, norm_mix_g[i], csh_a, csc_a)
        if m == 0:
            y, y_c = hgrn2_mixer(h, h_c, hg_w_in[j], hgrn2_lower_bound(hg_lb_logits, j),
                                 hg_norm_g[j], hg_w_out[j], ctx_next)
        elif m == 1:
            y, y_c = gdn_mixer(h, h_c, gdn_w_in[j], gdn_conv_w[j], gdn_a_log[j], gdn_dt_bias[j],
                               gdn_norm_g[j], gdn_w_out[j], ctx_next)
        else:
            y, y_c = na_mixer(h, h_c, na_w_qkv[j], na_q_norm_g[j], na_k_norm_g[j], na_rpb[j],
                              na_w_out[j], ctx_next)
        x = x + g_a * y
        x = x + g_f * conv_ffn(modulate(x, norm_ffn_g[i], sh_f, sc_f), ffn_w_up[i], ffn_conv_w[i], ffn_w_down[i])
        if ctx_next:
            ctx = ctx + cg_a * y_c
            ctx = ctx + cg_f * conv_ffn(modulate(ctx, norm_ffn_g[i], csh_f, csc_f),
                                        ffn_w_up[i], ffn_conv_w[i], ffn_w_down[i])
    return x
```

```cpp
#include <hip/hip_runtime.h>
#include <cstdio>
#include <cstdint>

#ifndef MK_ONE_LAUNCH
#define MK_ONE_LAUNCH 0
#endif

namespace pg8 {
#define PG8_LAS __attribute__((address_space(3)))
typedef unsigned short bf16_t;
typedef short bf16x8 __attribute__((ext_vector_type(8)));
typedef float f32x4 __attribute__((ext_vector_type(4)));
typedef unsigned u32x4 __attribute__((ext_vector_type(4)));
constexpr int BM = 256, BK = 64, HALF = 128, HTB = HALF * BK * 2  , STAGE_BYTES = 8 * HTB, NXCD = 8, WGM = 8;

__host__ __device__ __forceinline__ int lds_byte(int r, int c) { const int st = (r >> 4) * 2 + (c >> 5), rr = r & 15, cc = c & 31, ob = rr * 64 + cc * 2; return st * 1024 + (ob ^ (((ob >> 9) & 1) << 5)); }
__host__ __device__ __forceinline__ void stage_rc(int b, int& R, int& C) { const int st = b / 1024, sb = b % 1024, swz = sb ^ (((sb >> 9) & 1) << 5); R = (st >> 1) * 16 + swz / 64; C = (st & 1) * 32 + (swz % 64) / 2; }
__host__ __device__ __forceinline__ int perm32(int rho) { const int n = rho >> 4, i = rho & 15; return 8 * (i >> 2) + 4 * n + (i & 3); }

__device__ __forceinline__ int lane_id_asm() { int l; asm volatile("v_mbcnt_lo_u32_b32 %0, -1, 0\n\tv_mbcnt_hi_u32_b32 %0, -1, %0" : "=v"(l)); return l; }
struct Unit { int pm, pn; };
struct Gemm { const bf16_t* A; const bf16_t* Bt; int M, N, K, lda; };

struct StaticOrder {
    int nM, nN, nwg, G, c;
    __host__ __device__ void init(int M, int N, int G_, int c_) { nM = M / BM; nN = N / BM; nwg = nM * nN; G = G_; c = c_; }
    __host__ __device__ bool next(int i, Unit& u) const {
        const long L = (long)i * G + c; if (L >= nwg) return false;
        int wgid = (int)L; { const int q = nwg / NXCD, r = nwg % NXCD, xcd = wgid % NXCD, off = wgid / NXCD; wgid = (xcd < r ? xcd * (q + 1) : r * (q + 1) + (xcd - r) * q) + off; }
        const int nig = WGM * nN, gid = wgid / nig, fm = gid * WGM, gsz = (nM - fm) < WGM ? (nM - fm) : WGM;
        u.pm = fm + ((wgid % nig) % gsz); u.pn = (wgid % nig) / gsz; return true;
    }
    __device__ __forceinline__ void a_ready(const Unit&) const {}
    __device__ __forceinline__ void done(const Unit&) const {}
};

__device__ __forceinline__ unsigned cvt_pk_bf16(float lo, float hi) { unsigned r; asm volatile("v_cvt_pk_bf16_f32 %0, %1, %2" : "=v"(r) : "v"(lo), "v"(hi)); return r; }
typedef float f32x2 __attribute__((ext_vector_type(2)));

struct EpiStore {
    static constexpr bool PERM = true, AFTER_DRAIN = false;
    bf16_t* O; int ldc;
    __device__ __forceinline__ void operator()(const f32x4 (&acc)[2][2][4][2], const Unit& u, int wr, int wc, int fr, int fq) const {
        const int row0 = u.pm * BM + wr * 64 + fr; const int col0 = u.pn * BM + wc * 32 + 8 * fq;
#pragma unroll
        for (int ai = 0; ai < 2; ++ai)
#pragma unroll
            for (int m = 0; m < 4; ++m) { bf16_t* rowp = O + (size_t)(row0 + ai * HALF + m * 16) * ldc + col0;
#pragma unroll
                for (int bj = 0; bj < 2; ++bj) { const f32x4 v0 = acc[ai][bj][m][0], v1 = acc[ai][bj][m][1];
                    u32x4 w; w.x = cvt_pk_bf16(v0[0], v0[1]); w.y = cvt_pk_bf16(v0[2], v0[3]); w.z = cvt_pk_bf16(v1[0], v1[1]); w.w = cvt_pk_bf16(v1[2], v1[3]);
                    *(u32x4*)(rowp + bj * HALF) = w; } }
    }
};
struct EpiResid {
    static constexpr bool PERM = false, AFTER_DRAIN = false;
    const float* rl; const float* rc; float* ol; float* oc; const float* gate; int pm0;
    __device__ __forceinline__ void operator()(const f32x4 (&acc)[2][2][4][2], const Unit& u, int wr, int wc, int fr, int fq) const {
        const int pmg = u.pm + pm0; const bool isctx = pmg < 16;
        const int mr = isctx ? 16 : ((pmg - 16) >> 3);
        const size_t rowbase = isctx ? (size_t)pmg * 256 : (size_t)(pmg - 16) * 256;
        const float* rin = isctx ? rc : rl; float* ro = isctx ? oc : ol;
        const int row0 = wr * 64 + fr, col0 = u.pn * BM + wc * 32 + 4 * fq;
        f32x4 gv[2][2];
#pragma unroll
        for (int bj = 0; bj < 2; ++bj)
#pragma unroll
            for (int n = 0; n < 2; ++n) gv[bj][n] = *(const f32x4*)(gate + (size_t)mr * 12288 + col0 + bj * HALF + n * 16);
#pragma unroll
        for (int ai = 0; ai < 2; ++ai)
#pragma unroll
            for (int m = 0; m < 4; ++m) { const size_t off = (rowbase + row0 + ai * HALF + m * 16) * 2048 + col0;
#pragma unroll
                for (int bj = 0; bj < 2; ++bj)
#pragma unroll
                    for (int n = 0; n < 2; ++n) { const f32x4 r = *(const f32x4*)(rin + off + bj * HALF + n * 16);
                        *(f32x4*)(ro + off + bj * HALF + n * 16) = r + gv[bj][n] * acc[ai][bj][m][n]; } }
    }
};

template <class Epi, class Sched, bool ALIGN_EPI = false, bool SP2 = false>
__device__ __forceinline__ void gemm_phase(PG8_LAS unsigned char* lds, const Gemm g, const Sched& S, const Epi& E, const int wave_in) {
    const int lane = lane_id_asm(), wid = __builtin_amdgcn_readfirstlane(wave_in), tid = wid * 64 + lane, wr = wid >> 2, wc = wid & 3, fr = lane & 15, fq = lane >> 4;
    const int K = g.K, nt = K / BK;
    unsigned voffA[2], voffB[2];
#pragma unroll
    for (int i = 0; i < 2; ++i) { int R, C; stage_rc(tid * 16 + i * 8192, R, C); const int Rb = Epi::PERM ? ((R & ~31) + perm32(R & 31)) : R;
        voffA[i] = (unsigned)(R * g.lda + C) * 2u; voffB[i] = (unsigned)(Rb * K + C) * 2u; }
    const size_t kstep = (size_t)(BK * 2);
    const size_t hstepA = (size_t)HALF * g.lda * 2, hstepB = (size_t)HALF * K * 2;
    const size_t tstepA = 2 * hstepA, tstepB = 2 * hstepB;
    const unsigned ldsw = (unsigned)wid * 1024u;
    const int aoff = lds_byte(wr * 64 + fr, fq * 8), boff = lds_byte(wc * 32 + fr, fq * 8);
#define PG8_SA(b, h) (((b) * 2 + (h)) * HTB)
#define PG8_SB(b, h) ((4 + (b) * 2 + (h)) * HTB)
#define PG8_STAGE(bufoff, gbase, voff) do { _Pragma("unroll") for (int _i = 0; _i < 2; ++_i) \
        __builtin_amdgcn_global_load_lds((const unsigned*)((const char*)(gbase) + (voff)[_i]), (PG8_LAS unsigned*)(lds + (bufoff) + ldsw + _i * 8192), 16, 0, 0); } while (0)
#define PG8_LDA(dst, b, h) do { _Pragma("unroll") for (int m = 0; m < 4; ++m) _Pragma("unroll") for (int k = 0; k < 2; ++k) dst[m][k] = *(const PG8_LAS bf16x8*)(lds + PG8_SA(b, h) + aoff + m * 2048 + k * 1024); } while (0)
#define PG8_LDB(dst, b, h) do { _Pragma("unroll") for (int n = 0; n < 2; ++n) _Pragma("unroll") for (int k = 0; k < 2; ++k) dst[n][k] = *(const PG8_LAS bf16x8*)(lds + PG8_SB(b, h) + boff + n * 2048 + k * 1024); } while (0)
#define PG8_MMA(ai, bj, At, Bt) do { __builtin_amdgcn_s_setprio(1); _Pragma("unroll") for (int m = 0; m < 4; ++m) _Pragma("unroll") for (int n = 0; n < 2; ++n) _Pragma("unroll") for (int k = 0; k < 2; ++k) \
        acc[ai][bj][m][n] = __builtin_amdgcn_mfma_f32_16x16x32_bf16(Bt[n][k], At[m][k], acc[ai][bj][m][n], 0, 0, 0); __builtin_amdgcn_s_setprio(0); } while (0)
#define PG8_WAIT_V(n) asm volatile("s_waitcnt vmcnt(" #n ")" ::: "memory")
#define PG8_WAIT_L(n) asm volatile("s_waitcnt lgkmcnt(" #n ")" ::: "memory")
#define PG8_BAR __builtin_amdgcn_s_barrier()
#define PG8_SCHED __builtin_amdgcn_sched_barrier(0)
    Unit cur, nxt; int ui = 0;
    if (!S.next(0, cur)) return;
    f32x4 acc[2][2][4][2];
#pragma unroll
    for (int a = 0; a < 2; ++a)
#pragma unroll
        for (int b = 0; b < 2; ++b)
#pragma unroll
            for (int m = 0; m < 4; ++m)
#pragma unroll
                for (int n = 0; n < 2; ++n) acc[a][b][m][n] = (f32x4){0.f, 0.f, 0.f, 0.f};
    bf16x8 At[4][2], B0[2][2], B1[2][2];
    const char* cA = (const char*)g.A + (size_t)cur.pm * tstepA; const char* cB = (const char*)g.Bt + (size_t)cur.pn * tstepB;
    S.a_ready(cur);
    if constexpr (SP2) {
        PG8_STAGE(PG8_SB(0, 0), cB, voffB); PG8_STAGE(PG8_SB(0, 1), cB + hstepB, voffB); PG8_STAGE(PG8_SA(0, 0), cA, voffA); PG8_STAGE(PG8_SA(0, 1), cA + hstepA, voffA);
        if (wr == 1) PG8_BAR;
        PG8_WAIT_V(2); PG8_BAR;
        PG8_STAGE(PG8_SB(1, 0), cB + kstep, voffB); PG8_STAGE(PG8_SA(1, 0), cA + kstep, voffA); PG8_STAGE(PG8_SB(1, 1), cB + hstepB + kstep, voffB);
        PG8_WAIT_V(6); PG8_BAR;
    } else {
        PG8_STAGE(PG8_SB(0, 0), cB, voffB); PG8_STAGE(PG8_SA(0, 0), cA, voffA); PG8_STAGE(PG8_SB(0, 1), cB + hstepB, voffB); PG8_STAGE(PG8_SA(0, 1), cA + hstepA, voffA);
        if (wr == 1) PG8_BAR;
        PG8_WAIT_V(4); PG8_BAR;
        PG8_STAGE(PG8_SB(1, 0), cB + kstep, voffB); PG8_STAGE(PG8_SA(1, 0), cA + kstep, voffA); PG8_STAGE(PG8_SB(1, 1), cB + hstepB + kstep, voffB);
        PG8_WAIT_V(6); PG8_BAR;
    }
    for (;;) {
        const bool has_next = S.next(ui + 1, nxt);
        const char* nA = has_next ? (const char*)g.A + (size_t)nxt.pm * tstepA : cA; const char* nB = has_next ? (const char*)g.Bt + (size_t)nxt.pn * tstepB : cB;
        for (int t = 0; t < nt; t += 2) {
            const bool last = (t == nt - 2);
            const char* a1 = cA + (size_t)(t + 1) * kstep;
            const char* a2 = last ? nA : cA + (size_t)(t + 2) * kstep; const char* b2 = last ? nB : cB + (size_t)(t + 2) * kstep;
            const char* a3 = a2 + kstep; const char* b3 = b2 + kstep;
            if (last && has_next) S.a_ready(nxt);
            if constexpr (SP2) {
            PG8_LDB(B0, 0, 0); PG8_LDB(B1, 0, 1); PG8_SCHED; PG8_LDA(At, 0, 0); PG8_STAGE(PG8_SA(1, 1), a1 + hstepA, voffA);
            PG8_WAIT_V(8); PG8_WAIT_L(0); PG8_BAR; PG8_MMA(0, 0, At, B0); PG8_MMA(0, 1, At, B1); PG8_BAR; PG8_SCHED;
            PG8_LDA(At, 0, 1); PG8_STAGE(PG8_SB(0, 0), b2, voffB); PG8_STAGE(PG8_SB(0, 1), b2 + hstepB, voffB); PG8_STAGE(PG8_SA(0, 0), a2, voffA);
            PG8_WAIT_V(8); PG8_WAIT_L(0); PG8_BAR; PG8_MMA(1, 0, At, B0); PG8_MMA(1, 1, At, B1); PG8_BAR; PG8_SCHED;
            PG8_LDB(B0, 1, 0); PG8_LDB(B1, 1, 1); PG8_SCHED; PG8_LDA(At, 1, 0); PG8_STAGE(PG8_SA(0, 1), a2 + hstepA, voffA);
            PG8_WAIT_V(8); PG8_WAIT_L(0); PG8_BAR; PG8_MMA(0, 0, At, B0); PG8_MMA(0, 1, At, B1); PG8_BAR; PG8_SCHED;
            PG8_LDA(At, 1, 1); PG8_STAGE(PG8_SB(1, 0), b3, voffB); PG8_STAGE(PG8_SB(1, 1), b3 + hstepB, voffB); PG8_STAGE(PG8_SA(1, 0), a3, voffA);
            PG8_WAIT_V(8); PG8_WAIT_L(0); PG8_BAR; PG8_MMA(1, 0, At, B0); PG8_MMA(1, 1, At, B1); PG8_BAR; PG8_SCHED;
            } else {
            PG8_LDB(B0, 0, 0); PG8_SCHED; PG8_LDA(At, 0, 0); PG8_STAGE(PG8_SA(1, 1), a1 + hstepA, voffA);
            PG8_WAIT_L(8); PG8_BAR; PG8_WAIT_L(0); PG8_MMA(0, 0, At, B0); PG8_BAR; PG8_SCHED;
            PG8_LDB(B1, 0, 1); PG8_STAGE(PG8_SB(0, 0), b2, voffB);
            PG8_BAR; PG8_WAIT_L(0); PG8_MMA(0, 1, At, B1); PG8_BAR;
            PG8_LDA(At, 0, 1); PG8_STAGE(PG8_SA(0, 0), a2, voffA);
            PG8_BAR; PG8_WAIT_L(0); PG8_MMA(1, 0, At, B0); PG8_BAR; PG8_SCHED;
            PG8_STAGE(PG8_SB(0, 1), b2 + hstepB, voffB);
            PG8_WAIT_V(6); PG8_BAR; PG8_MMA(1, 1, At, B1); PG8_BAR;
            PG8_LDB(B0, 1, 0); PG8_SCHED; PG8_LDA(At, 1, 0); PG8_STAGE(PG8_SA(0, 1), a2 + hstepA, voffA);
            PG8_WAIT_L(8); PG8_BAR; PG8_WAIT_L(0); PG8_MMA(0, 0, At, B0); PG8_BAR; PG8_SCHED;
            PG8_LDB(B1, 1, 1); PG8_STAGE(PG8_SB(1, 0), b3, voffB);
            PG8_BAR; PG8_WAIT_L(0); PG8_MMA(0, 1, At, B1); PG8_BAR;
            PG8_LDA(At, 1, 1); PG8_STAGE(PG8_SA(1, 0), a3, voffA);
            PG8_BAR; PG8_WAIT_L(0); PG8_MMA(1, 0, At, B0); PG8_BAR; PG8_SCHED;
            PG8_STAGE(PG8_SB(1, 1), b3 + hstepB, voffB);
            PG8_WAIT_V(6); PG8_BAR; PG8_MMA(1, 1, At, B1); PG8_BAR;
            }
        }
        if constexpr (ALIGN_EPI) { if (wr == 0) PG8_BAR; }
        if constexpr (!Epi::AFTER_DRAIN) { E(acc, cur, wr, wc, fr, fq); S.done(cur); }
        if (!has_next) break;
#pragma unroll
        for (int a = 0; a < 2; ++a)
#pragma unroll
            for (int b = 0; b < 2; ++b)
#pragma unroll
                for (int m = 0; m < 4; ++m)
#pragma unroll
                    for (int n = 0; n < 2; ++n) acc[a][b][m][n] = (f32x4){0.f, 0.f, 0.f, 0.f};
        cur = nxt; cA = nA; cB = nB; ++ui;
        if constexpr (ALIGN_EPI) { if (wr == 1) PG8_BAR; }
    }
    PG8_WAIT_V(0);
    if constexpr (!ALIGN_EPI) { if (wr == 0) PG8_BAR; }
    PG8_BAR;
    if constexpr (Epi::AFTER_DRAIN) { E.fused(acc, cur, wr, wc, fr, fq, lds, wid, lane); S.done(cur); }
#undef PG8_SA
#undef PG8_SB
#undef PG8_STAGE
#undef PG8_LDA
#undef PG8_LDB
#undef PG8_MMA
#undef PG8_WAIT_V
#undef PG8_WAIT_L
#undef PG8_BAR
#undef PG8_SCHED
}
}

constexpr int DM = 2048, NB = 16, TL = 2048, TCX = 256, DEPTH = 4;
constexpr int ROWS_C = NB * TCX, ROWS_L = NB * TL, M_ALL = ROWS_C + ROWS_L;
constexpr int NMODC = 6 * DM;
constexpr int HG_N = 5 * DM;
constexpr int GDN_N = 12416, GDN_NP = 12544;
constexpr int NA_N = 3 * DM;
constexpr int DFF = 5504, UP_N = 2 * DFF;
constexpr float RMS_EPS = 1e-6f;
constexpr int NWAVES = 8, NTHREADS = 512;

constexpr size_t MiB = (size_t)1 << 20;
constexpr size_t WS_CTL = 0, CTL_ZERO_BYTES = 1 * MiB;
constexpr size_t WS_MOD = 1 * MiB;
constexpr size_t WS_CTXR = 5 * MiB;
constexpr size_t WS_WT_IN = 37 * MiB;
constexpr size_t WS_WT_OUT = 86 * MiB;
constexpr size_t WS_WT_UP = 102 * MiB;
constexpr size_t WS_WT_DN = 145 * MiB;
constexpr size_t WS_P = 167 * MiB;
constexpr size_t WS_O = 1049 * MiB;
constexpr size_t WS_H = 1337 * MiB;
constexpr size_t WS_END = 1481 * MiB;
constexpr int CW_BAR = 4096;

constexpr int LDS_BYTES = 163840;
constexpr int MISC_OFF = LDS_BYTES - 256;

#define GAS __attribute__((address_space(1)))
#define LAS __attribute__((address_space(3)))
typedef unsigned short bf16;
typedef unsigned v4u __attribute__((ext_vector_type(4)));
typedef unsigned v2u __attribute__((ext_vector_type(2)));
typedef float f32x4 __attribute__((ext_vector_type(4)));
typedef GAS const float* gcf;
typedef GAS float* gf;
typedef GAS const bf16* gcb;
typedef GAS bf16* gb;
#define LDS_WAIT() asm volatile("s_waitcnt lgkmcnt(0)" ::: "memory")
#define VM_WAIT() asm volatile("s_waitcnt vmcnt(0)" ::: "memory")
__device__ __forceinline__ unsigned f2bf(float f) { unsigned u = __builtin_bit_cast(unsigned, f); return (u + 0x7fffu + ((u >> 16) & 1u)) >> 16; }
__device__ __forceinline__ unsigned pk2(float lo, float hi) { return f2bf(lo) | (f2bf(hi) << 16); }
__device__ __forceinline__ float bflo(unsigned u) { return __builtin_bit_cast(float, u << 16); }
__device__ __forceinline__ float bfhi(unsigned u) { return __builtin_bit_cast(float, u & 0xffff0000u); }
__device__ __forceinline__ float bf2f(bf16 b) { return __builtin_bit_cast(float, (unsigned)b << 16); }
__device__ __forceinline__ float silu_f(float x) { return x / (1.f + __expf(-x)); }
__device__ __forceinline__ float sigmoid_f(float x) { return 1.f / (1.f + __expf(-x)); }
template <int CTRL> __device__ __forceinline__ float dppf(float x) { return __builtin_bit_cast(float, __builtin_amdgcn_mov_dpp(__builtin_bit_cast(int, x), CTRL, 0xf, 0xf, true)); }
__device__ __forceinline__ float sum8(float x) { x += dppf<0xB1>(x); x += dppf<0x4E>(x); x += dppf<0x141>(x); return x; }
__device__ __forceinline__ float max8(float x) { x = fmaxf(x, dppf<0xB1>(x)); x = fmaxf(x, dppf<0x4E>(x)); x = fmaxf(x, dppf<0x141>(x)); return x; }
__device__ __forceinline__ float sum16(float x) { x = sum8(x); x += dppf<0x128>(x); return x; }
__device__ __forceinline__ float sum32(float x) { x = sum16(x); auto s = __builtin_amdgcn_permlane16_swap(__float_as_uint(x), __float_as_uint(x), false, false); return __uint_as_float(s[0]) + __uint_as_float(s[1]); }
__device__ __forceinline__ float wave_sum(float x) { x = sum32(x); auto t = __builtin_amdgcn_permlane32_swap(__float_as_uint(x), __float_as_uint(x), false, false); return __uint_as_float(t[0]) + __uint_as_float(t[1]); }

#define XB_TMO      128
#define XB_XCNT(j)  (256  + 64 * (j))
#define XB_XSUB(j)  (1280 + 64 * (j))
#define XB_XGEN(j)  (2304 + 64 * (j))
#define XB_TOP      3328
#define XB_TOPGEN   3392
#define XCD_BAR_WORDS 3456
#define XB_SPIN_CAP (1u << 18)
__device__ __forceinline__ unsigned xb_ld(unsigned* p)              { return __hip_atomic_load(p, __ATOMIC_RELAXED, __HIP_MEMORY_SCOPE_AGENT); }
__device__ __forceinline__ unsigned xb_add(unsigned* p, unsigned v) { return __hip_atomic_fetch_add(p, v, __ATOMIC_RELAXED, __HIP_MEMORY_SCOPE_AGENT); }
__device__ __forceinline__ unsigned xb_xcc_id() { return (unsigned)__builtin_amdgcn_s_getreg((3 << 11) | 20) & 0xFu; }
#define XB_SPIN(cond, bar) do { unsigned _sp = 0; while (cond) { __builtin_amdgcn_s_sleep(1); \
    if ((++_sp & 255u) == 0u) { if (xb_ld(&(bar)[XB_TMO])) break; if (_sp > XB_SPIN_CAP) { atomicAdd(&(bar)[XB_TMO], 1u); break; } } } } while (0)
struct XcdBarrier { unsigned* bar; unsigned x; volatile LAS unsigned* st; };
__device__ __forceinline__ XcdBarrier xcd_barrier_post(unsigned* bar, volatile LAS unsigned* st, const int tid) {
    XcdBarrier b; b.bar = bar; b.x = xb_xcc_id(); b.st = st;
    if (tid == 0) (void)xb_add(&bar[XB_XCNT(b.x)], 1u);
    return b;
}
__device__ __forceinline__ void xcd_barrier_complete(unsigned* bar, unsigned x, unsigned& nloc, unsigned& nx) {
    const unsigned G = gridDim.x * gridDim.y * gridDim.z;
    unsigned sum, cnt, mine, sp = 0u;
    for (;;) {
        sum = 0u; cnt = 0u; mine = 0u;
#pragma unroll
        for (unsigned j = 0; j < 16; ++j) { const unsigned c = xb_ld(&bar[XB_XCNT(j)]); sum += c; cnt += (c > 0u) ? 1u : 0u; mine = (j == x) ? c : mine; }
        if (sum == G) break;
        __builtin_amdgcn_s_sleep(1);
        if ((++sp & 255u) == 0u) { if (xb_ld(&bar[XB_TMO])) break; if (sp > XB_SPIN_CAP) { atomicAdd(&bar[XB_TMO], 1u); break; } }
    }
    nloc = mine > 0u ? mine : 1u; nx = cnt > 0u ? cnt : 1u;
}
__device__ __forceinline__ void xcd_barrier(const XcdBarrier& b, const int tid) {
    asm volatile("s_waitcnt vmcnt(0)" ::: "memory");
    __syncthreads();
    if (tid == 0) {
        unsigned* bar = b.bar;
        __builtin_amdgcn_s_waitcnt(0);
        unsigned nloc = b.st[0], nx = b.st[1];
        if (nloc == 0u) { xcd_barrier_complete(bar, b.x, nloc, nx); b.st[0] = nloc; b.st[1] = nx; }
        const unsigned old = xb_add(&bar[XB_XSUB(b.x)], 1u);
        const unsigned gen = old / nloc;
        if (old + 1u == (gen + 1u) * nloc) {
            __builtin_amdgcn_fence(__ATOMIC_RELEASE, "agent");
            asm volatile("s_waitcnt vmcnt(0)" ::: "memory");
            const unsigned og = xb_add(&bar[XB_TOP], 1u);
            const unsigned tg = og / nx;
            if (og + 1u == (tg + 1u) * nx) xb_add(&bar[XB_TOPGEN], 1u);
            else XB_SPIN(xb_ld(&bar[XB_TOPGEN]) == tg, bar);
            __builtin_amdgcn_fence(__ATOMIC_ACQUIRE, "agent");
            xb_add(&bar[XB_XGEN(b.x)], 1u);
            asm volatile("s_waitcnt vmcnt(0)" ::: "memory");
        } else {
            XB_SPIN(xb_ld(&bar[XB_XGEN(b.x)]) == gen, bar);
            __builtin_amdgcn_fence(__ATOMIC_ACQUIRE, "agent");
            asm volatile("s_waitcnt vmcnt(0)" ::: "memory");
        }
    }
    __syncthreads();
}

struct Args { const float* in[26]; float* out; unsigned char* ws; int ph_lo, ph_hi; };
enum { I_X = 0, I_C, I_CTX, I_CCTX, I_ADAW, I_ADAB, I_NMG, I_NFG, I_HGWIN, I_HGLB, I_HGNG, I_HGWOUT, I_GDNWIN, I_GDNCW, I_GDNALOG, I_GDNDTB, I_GDNNG, I_GDNWOUT,
       I_NAWQKV, I_NAQG, I_NAKG, I_NARPB, I_NAWOUT, I_FFNUP, I_FFNCW, I_FFNDN };
#define FRAME_TID(F) do { (F).lane = pg8::lane_id_asm(); (F).tid = (F).wave * 64 + (F).lane; } while (0)
struct Frame {
    LAS unsigned char* lds;
    int tid, lane, wave, G, gw, NGW;
    gcf in[26];
    gf out;
    GAS unsigned char* ws;
};

__device__ __forceinline__ void transpose_item(gcf W, int K, int N, gb WT, LAS float* scr, int item, int lane) {
    const int nblk = N / 32, kb = item / nblk, nb = item % nblk, k0 = 64 * kb, n0 = 32 * nb;
#pragma unroll 8
    for (int i = 0; i < 32; ++i) { const int kk = 2 * i + (lane >> 5); scr[kk * 33 + (lane & 31)] = W[(size_t)(k0 + kk) * N + n0 + (lane & 31)]; }
    LDS_WAIT(); asm volatile("" ::: "memory");
    const int c = lane & 7;
#pragma unroll
    for (int j = 0; j < 4; ++j) { const int n = (lane >> 3) + 8 * j; const LAS float* s = scr + (8 * c) * 33 + n;
        v4u o; o.x = pk2(s[0 * 33], s[1 * 33]); o.y = pk2(s[2 * 33], s[3 * 33]); o.z = pk2(s[4 * 33], s[5 * 33]); o.w = pk2(s[6 * 33], s[7 * 33]);
        *(GAS v4u*)(WT + (size_t)(n0 + n) * K + k0 + 8 * c) = o; }
    LDS_WAIT(); asm volatile("" ::: "memory");
}

__device__ __forceinline__ void phase_mod(Frame& F) {
    FRAME_TID(F);
    LAS float* s = (LAS float*)F.lds;
    LAS float* red = s + 17 * 2048;
    for (int idx = F.tid; idx < 17 * 2048; idx += NTHREADS) { const int r = idx >> 11, k = idx & 2047; const float v = (r < 16) ? F.in[I_C][r * 2048 + k] : F.in[I_CCTX][k]; s[idx] = silu_f(v); }
    __syncthreads();
    const int cc = F.tid & 255, kh = F.tid >> 8;
    gf mod = (gf)(F.ws + WS_MOD);
    for (int item = blockIdx.x; item < 4 * 48; item += F.G) {
        const int i = item / 48, n = (item % 48) * 256 + cc;
        gcf w = F.in[I_ADAW] + ((size_t)i * 2048 + kh * 1024) * NMODC + n;
        float acc[17];
#pragma unroll
        for (int r = 0; r < 17; ++r) acc[r] = 0.f;
#pragma unroll 2
        for (int k = 0; k < 1024; k += 4) {
            const float w0 = w[(size_t)(k + 0) * NMODC], w1 = w[(size_t)(k + 1) * NMODC], w2 = w[(size_t)(k + 2) * NMODC], w3 = w[(size_t)(k + 3) * NMODC];
#pragma unroll
            for (int r = 0; r < 17; ++r) { const f32x4 sv = *(const LAS f32x4*)(s + r * 2048 + kh * 1024 + k); acc[r] += (sv.x * w0 + sv.y * w1) + (sv.z * w2 + sv.w * w3); }
        }
        if (kh == 1) {
#pragma unroll
            for (int r = 0; r < 17; ++r) red[r * 256 + cc] = acc[r];
        }
        __syncthreads();
        if (kh == 0) { const float bias = F.in[I_ADAB][i * NMODC + n];
#pragma unroll
            for (int r = 0; r < 17; ++r) mod[((size_t)i * 17 + r) * NMODC + n] = acc[r] + red[r * 256 + cc] + bias; }
        __syncthreads();
    }
}

__device__ __forceinline__ void phase_wprep(Frame& F, int L) {
    FRAME_TID(F);
    const int m = L % 3, j = L / 3;
    LAS float* scr = (LAS float*)(F.lds + F.wave * 16384);
    gcf Win = (m == 0) ? F.in[I_HGWIN] + (size_t)j * DM * HG_N : (m == 1) ? F.in[I_GDNWIN] : F.in[I_NAWQKV];
    const int Nin = (m == 0) ? HG_N : (m == 1) ? GDN_N : NA_N;
    gcf Wout = (m == 0) ? F.in[I_HGWOUT] + (size_t)j * DM * DM : (m == 1) ? F.in[I_GDNWOUT] : F.in[I_NAWOUT];
    const int Kout = (m == 1) ? 2 * DM : DM;
    gcf Wup = F.in[I_FFNUP] + (size_t)L * DM * UP_N;
    gcf Wdn = F.in[I_FFNDN] + (size_t)L * DFF * DM;
    gb Tin = (gb)(F.ws + WS_WT_IN), Tout = (gb)(F.ws + WS_WT_OUT), Tup = (gb)(F.ws + WS_WT_UP), Tdn = (gb)(F.ws + WS_WT_DN);
    const int I_in = (DM / 64) * (Nin / 32), I_out = (Kout / 64) * (DM / 32), I_up = (DM / 64) * (UP_N / 32), I_dn = (DFF / 64) * (DM / 32);
    const int total = I_in + I_out + I_up + I_dn;
    for (int it = F.gw; it < total; it += F.NGW) {
        int r = it;
        if (r < I_in) { transpose_item(Win, DM, Nin, Tin, scr, r, F.lane); continue; } r -= I_in;
        if (r < I_out) { transpose_item(Wout, Kout, DM, Tout, scr, r, F.lane); continue; } r -= I_out;
        if (r < I_up) { transpose_item(Wup, DM, UP_N, Tup, scr, r, F.lane); continue; } r -= I_up;
        transpose_item(Wdn, DFF, DM, Tdn, scr, r, F.lane);
    }
    if (m == 1) {
        GAS v4u* z = (GAS v4u*)(Tin + (size_t)GDN_N * DM);
        const int n16 = (GDN_NP - GDN_N) * DM * 2 / 16;
        for (int i = blockIdx.x * NTHREADS + F.tid; i < n16; i += F.G * NTHREADS) z[i] = (v4u){0u, 0u, 0u, 0u};
    }
}

__device__ __forceinline__ void phase_norm(Frame& F, gcf gvec, gcf modL, int chunk, gcf xlat, gcf xctx, int row_lo, int row_hi) {
    FRAME_TID(F);
    gb H = (gb)(F.ws + WS_H);
    const int nrows = row_hi - row_lo, rpw = (nrows + F.NGW - 1) / F.NGW;
    const int r0 = row_lo + F.gw * rpw, r1 = (r0 + rpw < row_hi) ? r0 + rpw : row_hi;
    int cur = -1; f32x4 Av[8], Bv[8];
    for (int r = r0; r < r1; ++r) {
        const int mr = (r < ROWS_C) ? 16 : ((r - ROWS_C) >> 11);
        if (mr != cur) { cur = mr;
#pragma unroll
            for (int jj = 0; jj < 8; ++jj) { const int c = (F.lane + 64 * jj) * 4;
                const f32x4 g4 = *(GAS const f32x4*)(gvec + c), sc = *(GAS const f32x4*)(modL + (size_t)mr * NMODC + (chunk + 1) * DM + c), sh = *(GAS const f32x4*)(modL + (size_t)mr * NMODC + chunk * DM + c);
                Av[jj] = g4 * (sc + 1.0f); Bv[jj] = sh; } }
        gcf xr = (r < ROWS_C) ? xctx + (size_t)r * DM : xlat + (size_t)(r - ROWS_C) * DM;
        f32x4 v[8]; float ss = 0.f;
#pragma unroll
        for (int jj = 0; jj < 8; ++jj) { v[jj] = *(GAS const f32x4*)(xr + (F.lane + 64 * jj) * 4); ss += (v[jj].x * v[jj].x + v[jj].y * v[jj].y) + (v[jj].z * v[jj].z + v[jj].w * v[jj].w); }
        const float rstd = __builtin_amdgcn_rsqf(wave_sum(ss) * (1.f / DM) + RMS_EPS);
        GAS v2u* o = (GAS v2u*)(H + (size_t)r * DM);
#pragma unroll
        for (int jj = 0; jj < 8; ++jj) { const f32x4 y = v[jj] * rstd * Av[jj] + Bv[jj]; o[F.lane + 64 * jj] = (v2u){pk2(y.x, y.y), pk2(y.z, y.w)}; }
    }
}

__device__ __forceinline__ void phase_convgate(Frame& F, int L, int row_lo, int row_hi) {
    FRAME_TID(F);
    gcb U = (gcb)(F.ws + WS_P); gb Gt = (gb)(F.ws + WS_O); gcf cw = F.in[I_FFNCW] + (size_t)L * 3 * UP_N;
    const int nitems = (row_hi - row_lo) / 32;
    for (int item = blockIdx.x; item < nitems; item += F.G) {
        const int r0 = row_lo + item * 32;
        const int sl = (r0 < ROWS_C) ? (r0 & 255) : ((r0 - ROWS_C) & 2047), slen = (r0 < ROWS_C) ? TCX : TL;
        const bool has_prev = sl > 0, has_next = (sl + 32) < slen;
        for (int q = 0; q < 2; ++q) {
            const int cg = F.tid + NTHREADS * q; if (cg >= DFF / 8) break;
            const int c = cg * 8;
            float wa[3][8], wb[3][8];
#pragma unroll
            for (int t = 0; t < 3; ++t)
#pragma unroll
                for (int e = 0; e < 8; ++e) { wa[t][e] = cw[t * UP_N + c + e]; wb[t][e] = cw[t * UP_N + DFF + c + e]; }
            float pa[8], pb[8], ca[8], cb[8], na[8], nb[8];
#define LD8(row, a, b) do { const v4u ra = *(GAS const v4u*)(U + (size_t)(row) * UP_N + c), rb = *(GAS const v4u*)(U + (size_t)(row) * UP_N + DFF + c); \
                a[0] = bflo(ra.x); a[1] = bfhi(ra.x); a[2] = bflo(ra.y); a[3] = bfhi(ra.y); a[4] = bflo(ra.z); a[5] = bfhi(ra.z); a[6] = bflo(ra.w); a[7] = bfhi(ra.w); \
                b[0] = bflo(rb.x); b[1] = bfhi(rb.x); b[2] = bflo(rb.y); b[3] = bfhi(rb.y); b[4] = bflo(rb.z); b[5] = bfhi(rb.z); b[6] = bflo(rb.w); b[7] = bfhi(rb.w); } while (0)
            if (has_prev) LD8(r0 - 1, pa, pb); else {
#pragma unroll
                for (int e = 0; e < 8; ++e) { pa[e] = 0.f; pb[e] = 0.f; } }
            LD8(r0, ca, cb);
            for (int i = 0; i < 32; ++i) {
                const int row = r0 + i;
                if (i < 31 || has_next) LD8(row + 1, na, nb); else {
#pragma unroll
                    for (int e = 0; e < 8; ++e) { na[e] = 0.f; nb[e] = 0.f; } }
                float g[8];
#pragma unroll
                for (int e = 0; e < 8; ++e) { const float a = pa[e] * wa[0][e] + ca[e] * wa[1][e] + na[e] * wa[2][e], b = pb[e] * wb[0][e] + cb[e] * wb[1][e] + nb[e] * wb[2][e]; g[e] = silu_f(a) * b; }
                *(GAS v4u*)(Gt + (size_t)row * DFF + c) = (v4u){pk2(g[0], g[1]), pk2(g[2], g[3]), pk2(g[4], g[5]), pk2(g[6], g[7])};
#pragma unroll
                for (int e = 0; e < 8; ++e) { pa[e] = ca[e]; pb[e] = cb[e]; ca[e] = na[e]; cb[e] = nb[e]; }
            }
        }
    }
}

__device__ __forceinline__ void phase_hg(Frame& F, int j, bool ctx_out) {
    FRAME_TID(F);
    gb P = (gb)(F.ws + WS_P); gf OF = (gf)(F.ws + WS_O);
    gcf lbl = F.in[I_HGLB]; gcf ng = F.in[I_HGNG] + j * 128;
    LAS float* qs = (LAS float*)F.lds; LAS float* ks = qs + 2048; LAS float* fs = ks + 2048; LAS float* vs = fs + 2048; LAS float* po = vs + 2048;
    const int v = F.tid & 127, kq = F.tid >> 7;
    const int ltok = F.tid >> 5, lc4 = (F.tid & 31) * 4;
    for (int item = blockIdx.x; item < NB * 16; item += F.G) {
        const int b = item >> 4, h = item & 15;
        for (int d = 0; d < 2; ++d) {
            float lbv[4];
#pragma unroll
            for (int e = 0; e < 4; ++e) { const float a0 = lbl[(0 * 2 + d) * DM + h * 128 + lc4 + e], a1 = lbl[(1 * 2 + d) * DM + h * 128 + lc4 + e];
                const float mx = fmaxf(a0, a1), e0 = __expf(a0 - mx), e1 = __expf(a1 - mx); lbv[e] = (j == 0) ? 0.f : e1 / (e0 + e1); }
            float ngv[4];
#pragma unroll
            for (int e = 0; e < 4; ++e) ngv[e] = ng[lc4 + e];
            float S[32];
#pragma unroll
            for (int e = 0; e < 32; ++e) S[e] = 0.f;
#pragma unroll 1
            for (int bt = 0; bt < (TCX + TL) / 16; ++bt) {
                const int s0 = bt * 16, pos = s0 + ltok;
                const int row = (s0 < TCX) ? (b * TCX + (d ? (TCX - 1 - pos) : pos)) : (ROWS_C + b * TL + (d ? (TL - 1 - (pos - TCX)) : (pos - TCX)));
                __syncthreads();
                {
                    gcb pr = P + (size_t)row * HG_N + h * 128 + lc4;
                    const v2u rq = *(GAS const v2u*)(pr), rv = *(GAS const v2u*)(pr + DM), rf = *(GAS const v2u*)(pr + (2 + d) * DM);
                    const float qv[4] = {bflo(rq.x), bfhi(rq.x), bflo(rq.y), bfhi(rq.y)}, fv[4] = {bflo(rf.x), bfhi(rf.x), bflo(rf.y), bfhi(rf.y)};
                    f32x4 q4, k4, f4;
#pragma unroll
                    for (int e = 0; e < 4; ++e) { q4[e] = silu_f(qv[e]); const float kk = (1.f - lbv[e]) * sigmoid_f(-fv[e]); k4[e] = kk; f4[e] = 1.f - kk; }
                    *(LAS f32x4*)(qs + ltok * 128 + lc4) = q4; *(LAS f32x4*)(ks + ltok * 128 + lc4) = k4; *(LAS f32x4*)(fs + ltok * 128 + lc4) = f4;
                    *(LAS f32x4*)(vs + ltok * 128 + lc4) = (f32x4){bflo(rv.x), bfhi(rv.x), bflo(rv.y), bfhi(rv.y)};
                }
                __syncthreads();
#pragma unroll 1
                for (int i = 0; i < 16; ++i) {
                    const float vv = vs[i * 128 + v]; float acc = 0.f;
#pragma unroll
                    for (int kk = 0; kk < 32; kk += 4) {
                        const f32x4 f4 = *(const LAS f32x4*)(fs + i * 128 + kq * 32 + kk), k4 = *(const LAS f32x4*)(ks + i * 128 + kq * 32 + kk), q4 = *(const LAS f32x4*)(qs + i * 128 + kq * 32 + kk);
#pragma unroll
                        for (int e = 0; e < 4; ++e) { S[kk + e] = f4[e] * S[kk + e] + k4[e] * vv; acc += S[kk + e] * q4[e]; }
                    }
                    po[(i * 4 + kq) * 128 + v] = acc;
                }
                __syncthreads();
                {
                    f32x4 o = *(const LAS f32x4*)(po + (ltok * 4 + 0) * 128 + lc4) + *(const LAS f32x4*)(po + (ltok * 4 + 1) * 128 + lc4)
                            + *(const LAS f32x4*)(po + (ltok * 4 + 2) * 128 + lc4) + *(const LAS f32x4*)(po + (ltok * 4 + 3) * 128 + lc4);
                    GAS f32x4* ofp = (GAS f32x4*)(OF + (size_t)row * DM + h * 128 + lc4);
                    if (d == 0) { *ofp = o; }
                    else if (ctx_out || s0 >= TCX) {
                        o = o + *ofp;
                        float ss = (o.x * o.x + o.y * o.y) + (o.z * o.z + o.w * o.w);
                        ss = sum32(ss);
                        const float r = __builtin_amdgcn_rsqf(ss * (1.f / 128.f) + RMS_EPS);
                        GAS v2u* gp = (GAS v2u*)(P + (size_t)row * HG_N + 4 * DM + h * 128 + lc4);
                        const v2u rg = *gp;
                        const float y0 = o.x * r * ngv[0] * silu_f(bflo(rg.x)), y1 = o.y * r * ngv[1] * silu_f(bfhi(rg.x)), y2 = o.z * r * ngv[2] * silu_f(bflo(rg.y)), y3 = o.w * r * ngv[3] * silu_f(bfhi(rg.y));
                        *gp = (v2u){pk2(y0, y1), pk2(y2, y3)};
                    }
                }
            }
            __threadfence(); __syncthreads();
        }
    }
}

__device__ __forceinline__ void phase_gdn(Frame& F, bool ctx_out) {
    FRAME_TID(F);
    gb P = (gb)(F.ws + WS_P); gb OB = (gb)(F.ws + WS_O);
    gcf cwt = F.in[I_GDNCW]; gcf alog = F.in[I_GDNALOG]; gcf dtb = F.in[I_GDNDTB]; gcf ng = F.in[I_GDNNG];
    LAS float* raw = (LAS float*)F.lds;
    LAS float* act = raw + 20 * 384;
    LAS float* red = act + 16 * 384;
    LAS float* ob = red + 2048;
    LAS float* bts = ob + 16 * 128;
    LAS float* egs = bts + 16;
    LAS float* kqd = egs + 16;
    const int v = F.tid & 127, kq = F.tid >> 7;
    const int c = F.tid;
    for (int item = blockIdx.x; item < NB * 32; item += F.G) {
        const int b = item >> 5, hv = item & 31, hq = hv >> 1;
        const int ccol = (c < 128) ? (hq * 128 + c) : (c < 256) ? (DM + hq * 128 + (c - 128)) : (2 * DM + hv * 128 + (c - 256));
        float cw[5];
#pragma unroll
        for (int t = 0; t < 5; ++t) cw[t] = (c < 384) ? cwt[t * (4 * DM) + ccol] : 0.f;
        for (int d = 0; d < 2; ++d) {
            const float dtbv = dtb[d * 32 + hv], aexp = __expf(alog[d * 32 + hv]);
            float S[32];
#pragma unroll
            for (int e = 0; e < 32; ++e) S[e] = 0.f;
#pragma unroll 1
            for (int bt = 0; bt < (TCX + TL) / 16; ++bt) {
                const int s0 = bt * 16;
                const bool isctx = s0 < TCX;
                const int slen = isctx ? TCX : TL, sp0 = isctx ? s0 : s0 - TCX;
                const int plo = d ? (slen - 16 - sp0) : sp0;
                const int rowbase = isctx ? b * TCX : ROWS_C + b * TL;
                __syncthreads();
                if (c < 384) {
#pragma unroll 4
                    for (int rr = 0; rr < 20; ++rr) { const int pp = plo - 2 + rr;
                        raw[rr * 384 + c] = (pp >= 0 && pp < slen) ? bf2f(P[(size_t)(rowbase + pp) * GDN_NP + ccol]) : 0.f; }
                } else if (F.tid < 400) { const int ti = F.tid - 384; const int pp = d ? (plo + 15 - ti) : (plo + ti);
                    gcb pr = P + (size_t)(rowbase + pp) * GDN_NP + 3 * 2 * DM + d * 64 + hv;
                    const float xb = bf2f(pr[0]), xa = bf2f(pr[32]) + dtbv;
                    const float sp = (xa > 20.f) ? xa : log1pf(__expf(xa));
                    bts[ti] = sigmoid_f(xb); egs[ti] = __expf(-aexp * sp); }
                __syncthreads();
                if (c < 384) {
#pragma unroll 2
                    for (int ip = 0; ip < 16; ++ip) {
                        const float a = raw[(ip + 0) * 384 + c] * cw[0] + raw[(ip + 1) * 384 + c] * cw[1] + raw[(ip + 2) * 384 + c] * cw[2] + raw[(ip + 3) * 384 + c] * cw[3] + raw[(ip + 4) * 384 + c] * cw[4];
                        act[(d ? 15 - ip : ip) * 384 + c] = silu_f(a);
                    }
                }
                __syncthreads();
#pragma unroll 1
                for (int tt = 0; tt < 2; ++tt) { const int ti = F.wave * 2 + tt;
                    LAS float* ar = act + ti * 384;
                    const float q0 = ar[F.lane], q1 = ar[64 + F.lane], k0 = ar[128 + F.lane], k1 = ar[192 + F.lane];
                    const float rq = __builtin_amdgcn_rsqf(wave_sum(q0 * q0 + q1 * q1) + RMS_EPS) * 0.08838834764831845f;
                    const float rk = __builtin_amdgcn_rsqf(wave_sum(k0 * k0 + k1 * k1) + RMS_EPS);
                    const float nq0 = q0 * rq, nq1 = q1 * rq, nk0 = k0 * rk, nk1 = k1 * rk;
                    ar[F.lane] = nq0; ar[64 + F.lane] = nq1; ar[128 + F.lane] = nk0; ar[192 + F.lane] = nk1;
                    const float kqs = wave_sum(nq0 * nk0 + nq1 * nk1);
                    if (F.lane == 0) kqd[ti] = kqs;
                }
                __syncthreads();
#pragma unroll 1
                for (int i = 0; i < 16; ++i) {
                    const int par = i & 1;
                    const float e_g = egs[i], be = bts[i];
                    const LAS float* ar = act + i * 384;
                    float dk = 0.f, dq = 0.f;
#pragma unroll
                    for (int kk = 0; kk < 32; kk += 4) {
                        const f32x4 k4 = *(const LAS f32x4*)(ar + 128 + kq * 32 + kk), q4 = *(const LAS f32x4*)(ar + kq * 32 + kk);
#pragma unroll
                        for (int e = 0; e < 4; ++e) { const float s = S[kk + e] * e_g; S[kk + e] = s; dk += k4[e] * s; dq += q4[e] * s; }
                    }
                    red[((par * 4 + kq) * 2 + 0) * 128 + v] = dk; red[((par * 4 + kq) * 2 + 1) * 128 + v] = dq;
                    __syncthreads();
                    dk = (red[((par * 4 + 0) * 2 + 0) * 128 + v] + red[((par * 4 + 1) * 2 + 0) * 128 + v]) + (red[((par * 4 + 2) * 2 + 0) * 128 + v] + red[((par * 4 + 3) * 2 + 0) * 128 + v]);
                    dq = (red[((par * 4 + 0) * 2 + 1) * 128 + v] + red[((par * 4 + 1) * 2 + 1) * 128 + v]) + (red[((par * 4 + 2) * 2 + 1) * 128 + v] + red[((par * 4 + 3) * 2 + 1) * 128 + v]);
                    const float dd = be * (ar[256 + v] - dk);
#pragma unroll
                    for (int kk = 0; kk < 32; kk += 4) {
                        const f32x4 k4 = *(const LAS f32x4*)(ar + 128 + kq * 32 + kk);
#pragma unroll
                        for (int e = 0; e < 4; ++e) S[kk + e] += k4[e] * dd;
                    }
                    if (kq == 0) ob[i * 128 + v] = dq + kqd[i] * dd;
                }
                __syncthreads();
                if (F.tid < 256) {
                    const int ti = F.tid >> 4, l16 = F.tid & 15;
                    const int pp = d ? (plo + 15 - ti) : (plo + ti), row = rowbase + pp;
                    const int vc = l16 * 8;
                    float o[8];
                    const f32x4 oa = *(const LAS f32x4*)(ob + ti * 128 + vc), obb = *(const LAS f32x4*)(ob + ti * 128 + vc + 4);
                    o[0] = oa.x; o[1] = oa.y; o[2] = oa.z; o[3] = oa.w; o[4] = obb.x; o[5] = obb.y; o[6] = obb.z; o[7] = obb.w;
                    GAS v4u* op = (GAS v4u*)(OB + (size_t)row * (2 * DM) + hv * 128 + vc);
                    if (d == 0) { *op = (v4u){pk2(o[0], o[1]), pk2(o[2], o[3]), pk2(o[4], o[5]), pk2(o[6], o[7])}; }
                    else if (ctx_out || !isctx) {
                        const v4u f = *op;
                        o[0] += bflo(f.x); o[1] += bfhi(f.x); o[2] += bflo(f.y); o[3] += bfhi(f.y); o[4] += bflo(f.z); o[5] += bfhi(f.z); o[6] += bflo(f.w); o[7] += bfhi(f.w);
                        float ss = 0.f;
#pragma unroll
                        for (int t = 0; t < 8; ++t) ss += o[t] * o[t];
                        ss = sum16(ss);
                        const float r = __builtin_amdgcn_rsqf(ss * (1.f / 128.f) + RMS_EPS);
                        GAS v4u* zp = (GAS v4u*)(P + (size_t)row * GDN_NP + 4 * DM + hv * 128 + vc);
                        const v4u z = *zp;
                        const float zz[8] = {bflo(z.x), bfhi(z.x), bflo(z.y), bfhi(z.y), bflo(z.z), bfhi(z.z), bflo(z.w), bfhi(z.w)};
                        float y[8];
#pragma unroll
                        for (int t = 0; t < 8; ++t) y[t] = o[t] * r * ng[vc + t] * silu_f(zz[t]);
                        *zp = (v4u){pk2(y[0], y[1]), pk2(y[2], y[3]), pk2(y[4], y[5]), pk2(y[6], y[7])};
                    }
                }
            }
            __threadfence(); __syncthreads();
        }
    }
}

__device__ __forceinline__ void phase_na(Frame& F, bool ctx_out) {
    FRAME_TID(F);
    gcb P = (gcb)(F.ws + WS_P); gb Oo = (gb)(F.ws + WS_O);
    gcf qg = F.in[I_NAQG], kg = F.in[I_NAKG], rpb = F.in[I_NARPB];
    LAS bf16* Kl = (LAS bf16*)F.lds; LAS bf16* Vl = Kl + 960 * 32; LAS float* bias = (LAS float*)(F.lds + 2 * 960 * 64);
    const int NLAT = NB * 64 * 8, NCTX = ctx_out ? NB * 64 * 4 : 0;
    const int qi = F.tid >> 3, sub = F.tid & 7;
    for (int item = blockIdx.x; item < NLAT + NCTX; item += F.G) {
        const bool lat = item < NLAT;
        const int it2 = lat ? item : item - NLAT;
        const int b = lat ? (it2 >> 9) : (it2 >> 8), h = lat ? ((it2 >> 3) & 63) : ((it2 >> 2) & 63), rg = lat ? (it2 & 7) : (it2 & 3);
        int Rlo = 0, nlat = 0;
        if (lat) { int lo = 4 * rg - 4; lo = lo < 0 ? 0 : (lo > 24 ? 24 : lo); int hi = 4 * rg + 3 - 4; hi = hi < 0 ? 0 : (hi > 24 ? 24 : hi); hi += 7; Rlo = lo; nlat = (hi - lo + 1) * 64; }
        __syncthreads();
        for (int kidx = F.tid; kidx < nlat + TCX; kidx += NTHREADS) {
            int slot, row;
            if (kidx < nlat) { slot = kidx; row = ROWS_C + b * TL + Rlo * 64 + kidx; } else { slot = 704 + (kidx - nlat); row = b * TCX + (kidx - nlat); }
            GAS const v4u* kp = (GAS const v4u*)(P + (size_t)row * NA_N + DM + h * 32); GAS const v4u* vp = (GAS const v4u*)(P + (size_t)row * NA_N + 2 * DM + h * 32);
            v4u kr[4], vr[4];
#pragma unroll
            for (int t = 0; t < 4; ++t) { kr[t] = kp[t]; vr[t] = vp[t]; }
            float kf[32]; float ss = 0.f;
#pragma unroll
            for (int t = 0; t < 4; ++t) { kf[8 * t + 0] = bflo(kr[t].x); kf[8 * t + 1] = bfhi(kr[t].x); kf[8 * t + 2] = bflo(kr[t].y); kf[8 * t + 3] = bfhi(kr[t].y);
                kf[8 * t + 4] = bflo(kr[t].z); kf[8 * t + 5] = bfhi(kr[t].z); kf[8 * t + 6] = bflo(kr[t].w); kf[8 * t + 7] = bfhi(kr[t].w); }
#pragma unroll
            for (int t = 0; t < 32; ++t) ss += kf[t] * kf[t];
            const float r = __builtin_amdgcn_rsqf(ss * (1.f / 32.f) + RMS_EPS);
#pragma unroll
            for (int t = 0; t < 32; ++t) kf[t] = kf[t] * r * kg[t];
#pragma unroll
            for (int t = 0; t < 4; ++t) { *(LAS v4u*)(Kl + slot * 32 + 8 * t) = (v4u){pk2(kf[8 * t], kf[8 * t + 1]), pk2(kf[8 * t + 2], kf[8 * t + 3]), pk2(kf[8 * t + 4], kf[8 * t + 5]), pk2(kf[8 * t + 6], kf[8 * t + 7])};
                *(LAS v4u*)(Vl + slot * 32 + 8 * t) = vr[t]; }
        }
        for (int idx = F.tid; idx < 15 * 31; idx += NTHREADS) bias[idx] = rpb[h * 465 + idx];
        __syncthreads();
        const int nqr = lat ? 4 : 1;
        for (int qr = 0; qr < nqr; ++qr) {
            const int r = rg * 4 + qr, cq = qi;
            const int qrow = lat ? (ROWS_C + b * TL + r * 64 + cq) : (b * TCX + rg * 64 + qi);
            float qf[32];
            {
                GAS const v4u* qp = (GAS const v4u*)(P + (size_t)qrow * NA_N + h * 32);
                float ss = 0.f;
#pragma unroll
                for (int t = 0; t < 4; ++t) { const v4u x = qp[t]; qf[8 * t + 0] = bflo(x.x); qf[8 * t + 1] = bfhi(x.x); qf[8 * t + 2] = bflo(x.y); qf[8 * t + 3] = bfhi(x.y);
                    qf[8 * t + 4] = bflo(x.z); qf[8 * t + 5] = bfhi(x.z); qf[8 * t + 6] = bflo(x.w); qf[8 * t + 7] = bfhi(x.w); }
#pragma unroll
                for (int t = 0; t < 32; ++t) ss += qf[t] * qf[t];
                const float rr = __builtin_amdgcn_rsqf(ss * (1.f / 32.f) + RMS_EPS) * 0.17677669529663687f;
#pragma unroll
                for (int t = 0; t < 32; ++t) qf[t] = qf[t] * rr * qg[t];
            }
            int r0 = r - 4; r0 = r0 < 0 ? 0 : (r0 > 24 ? 24 : r0);
            int c0 = cq - 8; c0 = c0 < 0 ? 0 : (c0 > 48 ? 48 : c0);
            const int krow = r0 + sub;
            const int lbase = (krow - Rlo) * 64 + c0;
            const int bbase = (krow - r + 7) * 31 + (c0 - cq + 15);
            float mrun = -INFINITY, l = 0.f, acc[32];
#pragma unroll
            for (int t = 0; t < 32; ++t) acc[t] = 0.f;
#pragma unroll 1
            for (int ch = lat ? 0 : 4; ch < 12; ++ch) {
                float s4[4]; int slot[4];
#pragma unroll
                for (int e = 0; e < 4; ++e) {
                    slot[e] = (ch < 4) ? (lbase + ch * 4 + e) : (704 + ((ch - 4) * 4 + e) * 8 + sub);
                    const LAS v4u* kp_ = (const LAS v4u*)(Kl + slot[e] * 32); float d_ = 0.f;
#pragma unroll
                    for (int t_ = 0; t_ < 4; ++t_) { const v4u x_ = kp_[t_];
                        d_ += qf[8 * t_ + 0] * bflo(x_.x) + qf[8 * t_ + 1] * bfhi(x_.x) + qf[8 * t_ + 2] * bflo(x_.y) + qf[8 * t_ + 3] * bfhi(x_.y)
                            + qf[8 * t_ + 4] * bflo(x_.z) + qf[8 * t_ + 5] * bfhi(x_.z) + qf[8 * t_ + 6] * bflo(x_.w) + qf[8 * t_ + 7] * bfhi(x_.w); }
                    s4[e] = (ch < 4) ? d_ + bias[bbase + ch * 4 + e] : d_;
                }
                const float mnew = fmaxf(fmaxf(fmaxf(s4[0], s4[1]), fmaxf(s4[2], s4[3])), mrun);
                const float corr = __expf(mrun - mnew);
                l *= corr;
#pragma unroll
                for (int t = 0; t < 32; ++t) acc[t] *= corr;
#pragma unroll
                for (int e = 0; e < 4; ++e) {
                    const float p = __expf(s4[e] - mnew); l += p;
                    const LAS v4u* vp_ = (const LAS v4u*)(Vl + slot[e] * 32);
#pragma unroll
                    for (int t_ = 0; t_ < 4; ++t_) { const v4u x_ = vp_[t_];
                        acc[8 * t_ + 0] += p * bflo(x_.x); acc[8 * t_ + 1] += p * bfhi(x_.x); acc[8 * t_ + 2] += p * bflo(x_.y); acc[8 * t_ + 3] += p * bfhi(x_.y);
                        acc[8 * t_ + 4] += p * bflo(x_.z); acc[8 * t_ + 5] += p * bfhi(x_.z); acc[8 * t_ + 6] += p * bflo(x_.w); acc[8 * t_ + 7] += p * bfhi(x_.w); }
                }
                mrun = mnew;
            }
            const float mall = max8(mrun);
            const float corr2 = __expf(mrun - mall);
            l *= corr2;
#pragma unroll
            for (int t = 0; t < 32; ++t) acc[t] *= corr2;
            l = sum8(l);
#pragma unroll
            for (int t = 0; t < 32; ++t) acc[t] = sum8(acc[t]);
            const float inv = 1.f / l;
            float o4[4];
#pragma unroll
            for (int t = 0; t < 4; ++t) { float x = acc[t];
#pragma unroll
                for (int s = 1; s < 8; ++s) x = (sub == s) ? acc[4 * s + t] : x;
                o4[t] = x * inv; }
            *(GAS v2u*)(Oo + (size_t)qrow * DM + h * 32 + 4 * sub) = (v2u){pk2(o4[0], o4[1]), pk2(o4[2], o4[3])};
        }
    }
}

constexpr int NPH = 1 + 8 * DEPTH;
#define IN(k) (lo <= (k) && (k) < hi)
#define SEAM(k) do { if (IN(k) && IN((k) + 1)) { FRAME_TID(F); xcd_barrier(bar, F.tid); } } while (0)
template <int L> __device__ __forceinline__ void layer_body(Frame& F, const Args& args, unsigned char* const wsg, const int lo, const int hi, const XcdBarrier& bar) {
        const int base = 1 + 8 * L, m = L % 3, j = L / 3;
        const bool last = (L == DEPTH - 1);
        gcf modL = (gcf)(F.ws + WS_MOD) + (size_t)L * 17 * NMODC;
        gcf xlat_in = (L == 0) ? F.in[I_X] : (gcf)F.out;
        gcf xctx_in = (L == 0) ? F.in[I_CTX] : (gcf)(F.ws + WS_CTXR);
        const int NinP = (m == 0) ? HG_N : (m == 1) ? GDN_NP : NA_N;
        const int row_lo2 = last ? ROWS_C : 0;
        const int pm02 = row_lo2 / 256;

        if (IN(base + 0)) {
            phase_wprep(F, L);
            phase_norm(F, F.in[I_NMG] + L * DM, modL, 0, xlat_in, xctx_in, 0, M_ALL);
            SEAM(base + 0);
        }
        if (IN(base + 1)) {
            pg8::Gemm g{(const pg8::bf16_t*)(wsg + WS_H), (const pg8::bf16_t*)(wsg + WS_WT_IN), M_ALL, NinP, DM, DM};
            pg8::StaticOrder S; S.init(M_ALL, NinP, F.G, (int)blockIdx.x);
            pg8::EpiStore E{(pg8::bf16_t*)(wsg + WS_P), NinP};
            pg8::gemm_phase<pg8::EpiStore, pg8::StaticOrder, true, true>(F.lds, g, S, E, F.wave);
            SEAM(base + 1);
        }
        if (IN(base + 2)) {
            if (m == 0) phase_hg(F, j, !last);
            else if (m == 1) phase_gdn(F, !last);
            else phase_na(F, !last);
            SEAM(base + 2);
        }
        if (IN(base + 3)) {
            const pg8::bf16_t* A = (m == 2) ? (const pg8::bf16_t*)(wsg + WS_O) : (const pg8::bf16_t*)(wsg + WS_P) + 4 * DM;
            const int lda = (m == 0) ? HG_N : (m == 1) ? GDN_NP : DM, Kout = (m == 1) ? 2 * DM : DM;
            const int Mr = M_ALL - row_lo2;
            pg8::Gemm g{A + (size_t)row_lo2 * lda, (const pg8::bf16_t*)(wsg + WS_WT_OUT), Mr, DM, Kout, lda};
            pg8::StaticOrder S; S.init(Mr, DM, F.G, (int)blockIdx.x);
            pg8::EpiResid E{(const float*)xlat_in, (const float*)xctx_in, args.out, (float*)(wsg + WS_CTXR), (const float*)modL + 2 * DM, pm02};
            pg8::gemm_phase<pg8::EpiResid, pg8::StaticOrder, true, true>(F.lds, g, S, E, F.wave);
            SEAM(base + 3);
        }
        if (IN(base + 4)) {
            phase_norm(F, F.in[I_NFG] + L * DM, modL, 3, (gcf)F.out, (gcf)(F.ws + WS_CTXR), row_lo2, M_ALL);
            SEAM(base + 4);
        }
        if (IN(base + 5)) {
            const int Mr = M_ALL - row_lo2;
            pg8::Gemm g{(const pg8::bf16_t*)(wsg + WS_H) + (size_t)row_lo2 * DM, (const pg8::bf16_t*)(wsg + WS_WT_UP), Mr, UP_N, DM, DM};
            pg8::StaticOrder S; S.init(Mr, UP_N, F.G, (int)blockIdx.x);
            pg8::EpiStore E{(pg8::bf16_t*)(wsg + WS_P) + (size_t)row_lo2 * UP_N, UP_N};
            pg8::gemm_phase<pg8::EpiStore, pg8::StaticOrder, true, true>(F.lds, g, S, E, F.wave);
            SEAM(base + 5);
        }
        if (IN(base + 6)) {
            phase_convgate(F, L, row_lo2, M_ALL);
            SEAM(base + 6);
        }
        if (IN(base + 7)) {
            const int Mr = M_ALL - row_lo2;
            pg8::Gemm g{(const pg8::bf16_t*)(wsg + WS_O) + (size_t)row_lo2 * DFF, (const pg8::bf16_t*)(wsg + WS_WT_DN), Mr, DM, DFF, DFF};
            pg8::StaticOrder S; S.init(Mr, DM, F.G, (int)blockIdx.x);
            pg8::EpiResid E{(const float*)args.out, (const float*)(wsg + WS_CTXR), args.out, (float*)(wsg + WS_CTXR), (const float*)(wsg + WS_MOD) + (size_t)L * 17 * NMODC + 5 * DM, pm02};
            pg8::gemm_phase<pg8::EpiResid, pg8::StaticOrder, true, true>(F.lds, g, S, E, F.wave);
            SEAM(base + 7);
        }
    }
#undef IN
#undef SEAM
__global__ void __launch_bounds__(NTHREADS, 2) fwd(Args args) {
    extern __shared__ __attribute__((aligned(16))) unsigned char lds_raw[];
    Frame F;
    F.lds = (LAS unsigned char*)lds_raw;
    F.wave = __builtin_amdgcn_readfirstlane((int)threadIdx.x >> 6); FRAME_TID(F);
    F.G = gridDim.x; F.gw = blockIdx.x * NWAVES + F.wave; F.NGW = F.G * NWAVES;
#pragma unroll
    for (int i = 0; i < 26; ++i) F.in[i] = (gcf)args.in[i];
    F.out = (gf)args.out; F.ws = (GAS unsigned char*)args.ws;
    unsigned char* const wsg = args.ws;
    volatile LAS unsigned* MISC = (volatile LAS unsigned*)(F.lds + MISC_OFF);
    if (F.tid < 64) MISC[F.tid] = 0u;
    __syncthreads();
    const int lo = args.ph_lo, hi = args.ph_hi;
    XcdBarrier bar; bar.bar = (unsigned*)(wsg + WS_CTL) + CW_BAR; bar.x = 0; bar.st = MISC + 8;
    if (hi - lo > 1) bar = xcd_barrier_post((unsigned*)(wsg + WS_CTL) + CW_BAR, MISC + 8, F.tid);
#define IN(k) (lo <= (k) && (k) < hi)
#define SEAM(k) do { if (IN(k) && IN((k) + 1)) { FRAME_TID(F); xcd_barrier(bar, F.tid); } } while (0)

    if (IN(0)) { phase_mod(F); SEAM(0); }

    layer_body<0>(F, args, wsg, lo, hi, bar);
    layer_body<1>(F, args, wsg, lo, hi, bar);
    layer_body<2>(F, args, wsg, lo, hi, bar);
    layer_body<3>(F, args, wsg, lo, hi, bar);
#undef IN
#undef SEAM
}

extern "C" void kernel_launch(void* const* d_in, const int* in_sizes, int n_in, void* d_out, int out_size, void* d_ws, size_t ws_size, hipStream_t stream) {
    static int grid = 0;
    if (grid == 0) {
        if (n_in != 26 || in_sizes[0] != ROWS_L * DM || out_size != ROWS_L * DM || ws_size < WS_END) {
            fprintf(stderr, "kernel_launch: unexpected shapes/workspace: n_in %d in0 %d out %d ws %zu (need %zu)\n", n_in, n_in > 0 ? in_sizes[0] : -1, out_size, ws_size, (size_t)WS_END); grid = -1; return; }
        int dev = 0, cus = 0;
        if (hipGetDevice(&dev) != hipSuccess || hipDeviceGetAttribute(&cus, hipDeviceAttributeMultiprocessorCount, dev) != hipSuccess) { grid = -1; return; }
        if (hipFuncSetAttribute((const void*)fwd, hipFuncAttributeMaxDynamicSharedMemorySize, LDS_BYTES) != hipSuccess) { fprintf(stderr, "kernel_launch: hipFuncSetAttribute failed\n"); grid = -1; return; }
        int per_cu = 0;
        if (hipOccupancyMaxActiveBlocksPerMultiprocessor(&per_cu, (const void*)fwd, NTHREADS, LDS_BYTES) != hipSuccess || per_cu < 1) fprintf(stderr, "kernel_launch: occupancy query reports %d\n", per_cu);
        (void)hipGetLastError();
        grid = cus;
    }
    if (grid < 0) return;
    if (hipMemsetAsync((char*)d_ws + WS_CTL, 0, CTL_ZERO_BYTES, stream) != hipSuccess) return;
    Args a{};
    for (int i = 0; i < 26; ++i) a.in[i] = (const float*)d_in[i];
    a.out = (float*)d_out; a.ws = (unsigned char*)d_ws;
#if MK_ONE_LAUNCH
    a.ph_lo = 0; a.ph_hi = NPH;
    hipLaunchKernelGGL(fwd, dim3(grid), dim3(NTHREADS), LDS_BYTES, stream, a);
#else
    for (int p = 0; p < NPH; ++p) { a.ph_lo = p; a.ph_hi = p + 1; hipLaunchKernelGGL(fwd, dim3(grid), dim3(NTHREADS), LDS_BYTES, stream, a); }
#endif
}
```

```cpp
#include <hip/hip_runtime.h>
#include <cstdio>
#include <cstdint>

#ifndef MK_ONE_LAUNCH
#define MK_ONE_LAUNCH 1
#endif

#ifndef PROBE_MIX
#define PROBE_MIX 0
#endif
#ifndef PROBE_THIN
#define PROBE_THIN 0
#endif
#ifndef PROBE_GEMM
#define PROBE_GEMM 0
#endif
#ifndef PROBE_BAR
#define PROBE_BAR 0
#endif
#ifndef PROBE_GDN
#define PROBE_GDN 0
#endif
namespace pg8 {
#define PG8_LAS __attribute__((address_space(3)))
typedef unsigned short bf16_t;
typedef short bf16x8 __attribute__((ext_vector_type(8)));
typedef float f32x4 __attribute__((ext_vector_type(4)));
typedef unsigned u32x4 __attribute__((ext_vector_type(4)));
constexpr int BM = 256, BK = 64, HALF = 128, HTB = HALF * BK * 2  , STAGE_BYTES = 8 * HTB, NXCD = 8, WGM = 4;

__host__ __device__ __forceinline__ int lds_byte(int r, int c) { const int st = (r >> 4) * 2 + (c >> 5), rr = r & 15, cc = c & 31, ob = rr * 64 + cc * 2; return st * 1024 + (ob ^ (((ob >> 9) & 1) << 5)); }
__host__ __device__ __forceinline__ void stage_rc(int b, int& R, int& C) { const int st = b / 1024, sb = b % 1024, swz = sb ^ (((sb >> 9) & 1) << 5); R = (st >> 1) * 16 + swz / 64; C = (st & 1) * 32 + (swz % 64) / 2; }
__host__ __device__ __forceinline__ int perm32(int rho) { const int n = rho >> 4, i = rho & 15; return 8 * (i >> 2) + 4 * n + (i & 3); }

__device__ __forceinline__ int lane_id_asm() { int l; asm volatile("v_mbcnt_lo_u32_b32 %0, -1, 0\n\tv_mbcnt_hi_u32_b32 %0, -1, %0" : "=v"(l)); return l; }
struct Unit { int pm, pn; };
struct Gemm { const bf16_t* A; const bf16_t* Bt; int M, N, K, lda; };

struct StaticOrder {
    int nM, nN, nwg, G, c;
    __host__ __device__ void init(int M, int N, int G_, int c_) { nM = M / BM; nN = N / BM; nwg = nM * nN; G = G_; c = c_; }
    __host__ __device__ bool next(int i, Unit& u) const {
        const long L = (long)i * G + c; if (L >= nwg) return false;
        int wgid = (int)L; { const int q = nwg / NXCD, r = nwg % NXCD, xcd = wgid % NXCD, off = wgid / NXCD; wgid = (xcd < r ? xcd * (q + 1) : r * (q + 1) + (xcd - r) * q) + off; }
        const int nig = WGM * nN, gid = wgid / nig, fm = gid * WGM, gsz = (nM - fm) < WGM ? (nM - fm) : WGM;
        u.pm = fm + ((wgid % nig) % gsz); u.pn = (wgid % nig) / gsz; return true;
    }
    __device__ __forceinline__ void a_ready(const Unit&) const {}
    __device__ __forceinline__ void done(const Unit&) const {}
};

struct ZeroOrder : StaticOrder {
    __host__ __device__ bool next(int i, Unit& u) const { const bool ok = StaticOrder::next(i, u); u.pm = 0; u.pn = 0; return ok; }
};

__device__ __forceinline__ unsigned cvt_pk_bf16(float lo, float hi) { unsigned r; asm volatile("v_cvt_pk_bf16_f32 %0, %1, %2" : "=v"(r) : "v"(lo), "v"(hi)); return r; }
typedef float f32x2 __attribute__((ext_vector_type(2)));

struct EpiStore {
    static constexpr bool PERM = true, AFTER_DRAIN = false;
    bf16_t* O; int ldc; int a0lo, a0hi, a1lo, a1hi;
    __device__ __forceinline__ void operator()(const f32x4 (&acc)[2][2][4][2], const Unit& u, int wr, int wc, int fr, int fq) const {
        const int row0 = u.pm * BM + wr * 64 + fr; const int col0 = u.pn * BM + wc * 32 + 8 * fq;
        const bool act = (u.pn >= a0lo && u.pn < a0hi) || (u.pn >= a1lo && u.pn < a1hi);
#pragma unroll
        for (int ai = 0; ai < 2; ++ai)
#pragma unroll
            for (int m = 0; m < 4; ++m) { bf16_t* rowp = O + (size_t)(row0 + ai * HALF + m * 16) * ldc + col0;
#pragma unroll
                for (int bj = 0; bj < 2; ++bj) { f32x4 v0 = acc[ai][bj][m][0], v1 = acc[ai][bj][m][1];
                    if (act) {
#pragma unroll
                        for (int e = 0; e < 4; ++e) { v0[e] = v0[e] * __builtin_amdgcn_rcpf(1.f + __expf(-v0[e])); v1[e] = v1[e] * __builtin_amdgcn_rcpf(1.f + __expf(-v1[e])); } }
                    u32x4 w; w.x = cvt_pk_bf16(v0[0], v0[1]); w.y = cvt_pk_bf16(v0[2], v0[3]); w.z = cvt_pk_bf16(v1[0], v1[1]); w.w = cvt_pk_bf16(v1[2], v1[3]);
                    *(u32x4*)(rowp + bj * HALF) = w; } }
    }
};
typedef _Float16 h16x4 __attribute__((ext_vector_type(4)));
typedef unsigned u32x2 __attribute__((ext_vector_type(2)));
__device__ __forceinline__ u32x2 f4_to_h4(f32x4 v) { return __builtin_bit_cast(u32x2, __builtin_convertvector(v, h16x4)); }
__device__ __forceinline__ f32x4 h4_to_f4(u32x2 w) { return __builtin_convertvector(__builtin_bit_cast(h16x4, w), f32x4); }
template <bool IN16, bool OUT16>
struct EpiResidT {
    static constexpr bool PERM = true, AFTER_DRAIN = false;
    const float* rl; const float* rc; const _Float16* xin; _Float16* xout; float* ol; const float* gate; int pm0; int dry;
    __device__ __forceinline__ void operator()(const f32x4 (&acc)[2][2][4][2], const Unit& u, int wr, int wc, int fr, int fq) const {
        const int pmg = u.pm + pm0; const bool isctx = pmg < 16;
        const int mr = isctx ? 16 : ((pmg - 16) >> 3);
        const size_t urow0 = (size_t)pmg * 256 + wr * 64 + fr;
        const size_t lrow0 = isctx ? urow0 : urow0 - 4096;
        const float* rin = isctx ? rc : rl;
        const int col0 = u.pn * BM + wc * 32 + 8 * fq;
        f32x4 gv[2][2];
#pragma unroll
        for (int bj = 0; bj < 2; ++bj)
#pragma unroll
            for (int n = 0; n < 2; ++n) gv[bj][n] = *(const f32x4*)(gate + (size_t)mr * 12288 + col0 + bj * HALF + 4 * n);
#pragma unroll
        for (int ai = 0; ai < 2; ++ai) {
            f32x4 r[4][2][2];
            if constexpr (IN16) {
                u32x4 rh[4][2];
#pragma unroll
                for (int m = 0; m < 4; ++m)
#pragma unroll
                    for (int bj = 0; bj < 2; ++bj) rh[m][bj] = *(const u32x4*)(xin + (urow0 + ai * HALF + m * 16) * 2048 + col0 + bj * HALF);
#pragma unroll
                for (int m = 0; m < 4; ++m)
#pragma unroll
                    for (int bj = 0; bj < 2; ++bj) { r[m][bj][0] = h4_to_f4((u32x2){rh[m][bj].x, rh[m][bj].y}); r[m][bj][1] = h4_to_f4((u32x2){rh[m][bj].z, rh[m][bj].w}); }
            } else {
#pragma unroll
                for (int m = 0; m < 4; ++m)
#pragma unroll
                    for (int bj = 0; bj < 2; ++bj)
#pragma unroll
                        for (int n = 0; n < 2; ++n) r[m][bj][n] = *(const f32x4*)(rin + (lrow0 + ai * HALF + m * 16) * 2048 + col0 + bj * HALF + 4 * n);
            }
#pragma unroll
            for (int m = 0; m < 4; ++m)
#pragma unroll
                for (int bj = 0; bj < 2; ++bj) {
                    const f32x4 v0 = r[m][bj][0] + gv[bj][0] * acc[ai][bj][m][0], v1 = r[m][bj][1] + gv[bj][1] * acc[ai][bj][m][1];
                    if (!dry || v0.x == 1.2345e30f) {
                        if constexpr (OUT16) { const u32x2 h0 = f4_to_h4(v0), h1 = f4_to_h4(v1); *(u32x4*)(xout + (urow0 + ai * HALF + m * 16) * 2048 + col0 + bj * HALF) = (u32x4){h0.x, h0.y, h1.x, h1.y}; }
                        else { float* op = ol + (lrow0 + ai * HALF + m * 16) * 2048 + col0 + bj * HALF; *(f32x4*)op = v0; *(f32x4*)(op + 4) = v1; }
                    }
                }
        }
    }
};

template <int CTRL> __device__ __forceinline__ float dppmov(float x) { return __builtin_bit_cast(float, __builtin_amdgcn_mov_dpp(__builtin_bit_cast(int, x), CTRL, 0xf, 0xf, true)); }
template <int CTRL> __device__ __forceinline__ float dppupd(float old, float x) { return __builtin_bit_cast(float, __builtin_amdgcn_update_dpp(__builtin_bit_cast(int, old), __builtin_bit_cast(int, x), CTRL, 0xf, 0xf, false)); }
struct EpiConvGate {
    static constexpr bool PERM = true, AFTER_DRAIN = false;
    bf16_t* G; bf16_t* SIDE; const float* cw; int pm0;
    __device__ __forceinline__ void operator()(const f32x4 (&acc)[2][2][4][2], const Unit& u, int wr, int wc, int fr, int fq) const {
        const int cc0 = wc * 32 + 8 * fq;
        const int jg0 = u.pn * 128 + cc0;
        f32x4 wa2[2][3], wb2[2][3];
#pragma unroll
        for (int n = 0; n < 2; ++n)
#pragma unroll
            for (int t = 0; t < 3; ++t) { wa2[n][t] = *(const f32x4*)(cw + t * 11008 + jg0 + 4 * n); wb2[n][t] = *(const f32x4*)(cw + t * 11008 + 5504 + jg0 + 4 * n); }
        asm volatile("" :: "v"(wa2[0][0]), "v"(wa2[0][1]), "v"(wa2[0][2]), "v"(wb2[0][0]), "v"(wb2[0][1]), "v"(wb2[0][2]), "v"(wa2[1][0]), "v"(wa2[1][1]), "v"(wa2[1][2]), "v"(wb2[1][0]), "v"(wb2[1][1]), "v"(wb2[1][2]));
#pragma unroll
        for (int ai = 0; ai < 2; ++ai)
#pragma unroll
            for (int m = 0; m < 4; ++m) {
                unsigned gq[4];
#pragma unroll
                for (int n = 0; n < 2; ++n) {
                    const f32x4 (&wa)[3] = wa2[n]; const f32x4 (&wb)[3] = wb2[n];
                    f32x4 ga;
#pragma unroll
                    for (int e = 0; e < 4; ++e) {
                        const float ac = acc[ai][0][m][n][e], bc = acc[ai][1][m][n][e];
                        const float apo = (m > 0) ? dppmov<0x121>(acc[ai][0][m > 0 ? m - 1 : 0][n][e]) : 0.f, bpo = (m > 0) ? dppmov<0x121>(acc[ai][1][m > 0 ? m - 1 : 0][n][e]) : 0.f;
                        const float ano = (m < 3) ? dppmov<0x12F>(acc[ai][0][m < 3 ? m + 1 : 3][n][e]) : 0.f, bno = (m < 3) ? dppmov<0x12F>(acc[ai][1][m < 3 ? m + 1 : 3][n][e]) : 0.f;
                        const float ap = dppupd<0x111>(apo, ac), bp = dppupd<0x111>(bpo, bc);
                        const float an = dppupd<0x101>(ano, ac), bn = dppupd<0x101>(bno, bc);
                        const float a = ap * wa[0][e] + ac * wa[1][e] + an * wa[2][e], b = bp * wb[0][e] + bc * wb[1][e] + bn * wb[2][e];
                        ga[e] = a * __builtin_amdgcn_rcpf(1.f + __expf(-a)) * b;
                    }
                    gq[2 * n] = cvt_pk_bf16(ga[0], ga[1]); gq[2 * n + 1] = cvt_pk_bf16(ga[2], ga[3]);
                }
                const int sl = 16 * m + fr;
                const size_t row = (size_t)u.pm * BM + ai * HALF + wr * 64 + sl;
                if (sl != 0 && sl != 63) *(u32x4*)(G + row * 5504 + jg0) = (u32x4){gq[0], gq[1], gq[2], gq[3]};
                if (sl <= 1 || sl >= 62) {
                    const int which = (sl <= 1) ? sl : sl - 60;
                    const size_t strip = (size_t)(u.pm + pm0) * 4 + ai * 2 + wr;
                    bf16_t* sp = SIDE + (strip * 4 + which) * 11008 + u.pn * BM + cc0;
                    *(u32x4*)sp = (u32x4){cvt_pk_bf16(acc[ai][0][m][0][0], acc[ai][0][m][0][1]), cvt_pk_bf16(acc[ai][0][m][0][2], acc[ai][0][m][0][3]), cvt_pk_bf16(acc[ai][0][m][1][0], acc[ai][0][m][1][1]), cvt_pk_bf16(acc[ai][0][m][1][2], acc[ai][0][m][1][3])};
                    *(u32x4*)(sp + HALF) = (u32x4){cvt_pk_bf16(acc[ai][1][m][0][0], acc[ai][1][m][0][1]), cvt_pk_bf16(acc[ai][1][m][0][2], acc[ai][1][m][0][3]), cvt_pk_bf16(acc[ai][1][m][1][0], acc[ai][1][m][1][1]), cvt_pk_bf16(acc[ai][1][m][1][2], acc[ai][1][m][1][3])};
                }
            }
    }
};


struct EpiNull {
    static constexpr bool PERM = true, AFTER_DRAIN = false;
    bf16_t* O;
    __device__ __forceinline__ void operator()(const f32x4 (&acc)[2][2][4][2], const Unit& u, int wr, int wc, int fr, int fq) const {
        f32x4 s = (f32x4){0.f, 0.f, 0.f, 0.f};
#pragma unroll
        for (int ai = 0; ai < 2; ++ai)
#pragma unroll
            for (int bj = 0; bj < 2; ++bj)
#pragma unroll
                for (int m = 0; m < 4; ++m)
#pragma unroll
                    for (int n = 0; n < 2; ++n) s = s + acc[ai][bj][m][n];
        if (s.x == 1.2345e30f) *(f32x4*)(O + (size_t)u.pm * 8) = s;
    }
};
template <class Epi, class Sched, bool ALIGN_EPI = false, bool SP2 = false>
__device__ __forceinline__ void gemm_phase(PG8_LAS unsigned char* lds, const Gemm g, const Sched& S, const Epi& E, const int wave_in) {
    const int lane = lane_id_asm(), wid = __builtin_amdgcn_readfirstlane(wave_in), tid = wid * 64 + lane, wr = wid >> 2, wc = wid & 3, fr = lane & 15, fq = lane >> 4;
    const int K = g.K, nt = K / BK;
    unsigned voffA[2], voffB[2];
#pragma unroll
    for (int i = 0; i < 2; ++i) { int R, C; stage_rc(tid * 16 + i * 8192, R, C); const int Rb = Epi::PERM ? ((R & ~31) + perm32(R & 31)) : R;
        voffA[i] = (unsigned)(R * g.lda + C) * 2u; voffB[i] = (unsigned)(Rb * K + C) * 2u; }
    const size_t kstep = (size_t)(BK * 2);
    const size_t hstepA = (size_t)HALF * g.lda * 2, hstepB = (size_t)HALF * K * 2;
    const size_t tstepA = 2 * hstepA, tstepB = 2 * hstepB;
    const unsigned ldsw = (unsigned)wid * 1024u;
    const int aoff = lds_byte(wr * 64 + fr, fq * 8), boff = lds_byte(wc * 32 + fr, fq * 8);
#define PG8_SA(b, h) (((b) * 2 + (h)) * HTB)
#define PG8_SB(b, h) ((4 + (b) * 2 + (h)) * HTB)
#define PG8_STAGE(bufoff, gbase, voff) do { _Pragma("unroll") for (int _i = 0; _i < 2; ++_i) \
        __builtin_amdgcn_global_load_lds((const unsigned*)((const char*)(gbase) + (voff)[_i]), (PG8_LAS unsigned*)(lds + (bufoff) + ldsw + _i * 8192), 16, 0, 0); } while (0)
#define PG8_LDA(dst, b, h) do { _Pragma("unroll") for (int m = 0; m < 4; ++m) _Pragma("unroll") for (int k = 0; k < 2; ++k) dst[m][k] = *(const PG8_LAS bf16x8*)(lds + PG8_SA(b, h) + aoff + m * 2048 + k * 1024); } while (0)
#define PG8_LDB(dst, b, h) do { _Pragma("unroll") for (int n = 0; n < 2; ++n) _Pragma("unroll") for (int k = 0; k < 2; ++k) dst[n][k] = *(const PG8_LAS bf16x8*)(lds + PG8_SB(b, h) + boff + n * 2048 + k * 1024); } while (0)
#define PG8_MMA(ai, bj, At, Bt) do { __builtin_amdgcn_s_setprio(1); _Pragma("unroll") for (int m = 0; m < 4; ++m) _Pragma("unroll") for (int n = 0; n < 2; ++n) _Pragma("unroll") for (int k = 0; k < 2; ++k) \
        acc[ai][bj][m][n] = __builtin_amdgcn_mfma_f32_16x16x32_bf16(Bt[n][k], At[m][k], acc[ai][bj][m][n], 0, 0, 0); __builtin_amdgcn_s_setprio(0); } while (0)
#define PG8_WAIT_V(n) asm volatile("s_waitcnt vmcnt(" #n ")" ::: "memory")
#define PG8_WAIT_L(n) asm volatile("s_waitcnt lgkmcnt(" #n ")" ::: "memory")
#define PG8_BAR __builtin_amdgcn_s_barrier()
#define PG8_SCHED __builtin_amdgcn_sched_barrier(0)
    Unit cur, nxt; int ui = 0;
    if (!S.next(0, cur)) return;
    f32x4 acc[2][2][4][2];
#pragma unroll
    for (int a = 0; a < 2; ++a)
#pragma unroll
        for (int b = 0; b < 2; ++b)
#pragma unroll
            for (int m = 0; m < 4; ++m)
#pragma unroll
                for (int n = 0; n < 2; ++n) acc[a][b][m][n] = (f32x4){0.f, 0.f, 0.f, 0.f};
    bf16x8 At[4][2], B0[2][2], B1[2][2];
    const char* cA = (const char*)g.A + (size_t)cur.pm * tstepA; const char* cB = (const char*)g.Bt + (size_t)cur.pn * tstepB;
    S.a_ready(cur);
    if constexpr (SP2) {
        PG8_STAGE(PG8_SB(0, 0), cB, voffB); PG8_STAGE(PG8_SB(0, 1), cB + hstepB, voffB); PG8_STAGE(PG8_SA(0, 0), cA, voffA); PG8_STAGE(PG8_SA(0, 1), cA + hstepA, voffA);
        if (wr == 1) PG8_BAR;
        PG8_WAIT_V(2); PG8_BAR;
        PG8_STAGE(PG8_SB(1, 0), cB + kstep, voffB); PG8_STAGE(PG8_SA(1, 0), cA + kstep, voffA); PG8_STAGE(PG8_SB(1, 1), cB + hstepB + kstep, voffB);
        PG8_WAIT_V(6); PG8_BAR;
    } else {
        PG8_STAGE(PG8_SB(0, 0), cB, voffB); PG8_STAGE(PG8_SA(0, 0), cA, voffA); PG8_STAGE(PG8_SB(0, 1), cB + hstepB, voffB); PG8_STAGE(PG8_SA(0, 1), cA + hstepA, voffA);
        if (wr == 1) PG8_BAR;
        PG8_WAIT_V(4); PG8_BAR;
        PG8_STAGE(PG8_SB(1, 0), cB + kstep, voffB); PG8_STAGE(PG8_SA(1, 0), cA + kstep, voffA); PG8_STAGE(PG8_SB(1, 1), cB + hstepB + kstep, voffB);
        PG8_WAIT_V(6); PG8_BAR;
    }
    for (;;) {
        const bool has_next = S.next(ui + 1, nxt);
        const char* nA = has_next ? (const char*)g.A + (size_t)nxt.pm * tstepA : cA; const char* nB = has_next ? (const char*)g.Bt + (size_t)nxt.pn * tstepB : cB;
        for (int t = 0; t < nt; t += 2) {
            const bool last = (t == nt - 2);
            const char* a1 = cA + (size_t)(t + 1) * kstep;
            const char* a2 = last ? nA : cA + (size_t)(t + 2) * kstep; const char* b2 = last ? nB : cB + (size_t)(t + 2) * kstep;
            const char* a3 = a2 + kstep; const char* b3 = b2 + kstep;
            if (last && has_next) S.a_ready(nxt);
            if constexpr (SP2) {
            PG8_LDB(B0, 0, 0); PG8_LDB(B1, 0, 1); PG8_SCHED; PG8_LDA(At, 0, 0); PG8_STAGE(PG8_SA(1, 1), a1 + hstepA, voffA);
            PG8_WAIT_V(8); PG8_WAIT_L(0); PG8_BAR; PG8_MMA(0, 0, At, B0); PG8_MMA(0, 1, At, B1); PG8_BAR; PG8_SCHED;
            PG8_LDA(At, 0, 1); PG8_STAGE(PG8_SB(0, 0), b2, voffB); PG8_STAGE(PG8_SB(0, 1), b2 + hstepB, voffB); PG8_STAGE(PG8_SA(0, 0), a2, voffA);
            PG8_WAIT_V(8); PG8_WAIT_L(0); PG8_BAR; PG8_MMA(1, 0, At, B0); PG8_MMA(1, 1, At, B1); PG8_BAR; PG8_SCHED;
            PG8_LDB(B0, 1, 0); PG8_LDB(B1, 1, 1); PG8_SCHED; PG8_LDA(At, 1, 0); PG8_STAGE(PG8_SA(0, 1), a2 + hstepA, voffA);
            PG8_WAIT_V(8); PG8_WAIT_L(0); PG8_BAR; PG8_MMA(0, 0, At, B0); PG8_MMA(0, 1, At, B1); PG8_BAR; PG8_SCHED;
            PG8_LDA(At, 1, 1); PG8_STAGE(PG8_SB(1, 0), b3, voffB); PG8_STAGE(PG8_SB(1, 1), b3 + hstepB, voffB); PG8_STAGE(PG8_SA(1, 0), a3, voffA);
            PG8_WAIT_V(8); PG8_WAIT_L(0); PG8_BAR; PG8_MMA(1, 0, At, B0); PG8_MMA(1, 1, At, B1); PG8_BAR; PG8_SCHED;
            } else {
            PG8_LDB(B0, 0, 0); PG8_SCHED; PG8_LDA(At, 0, 0); PG8_STAGE(PG8_SA(1, 1), a1 + hstepA, voffA);
            PG8_WAIT_L(8); PG8_BAR; PG8_WAIT_L(0); PG8_MMA(0, 0, At, B0); PG8_BAR; PG8_SCHED;
            PG8_LDB(B1, 0, 1); PG8_STAGE(PG8_SB(0, 0), b2, voffB);
            PG8_BAR; PG8_WAIT_L(0); PG8_MMA(0, 1, At, B1); PG8_BAR;
            PG8_LDA(At, 0, 1); PG8_STAGE(PG8_SA(0, 0), a2, voffA);
            PG8_BAR; PG8_WAIT_L(0); PG8_MMA(1, 0, At, B0); PG8_BAR; PG8_SCHED;
            PG8_STAGE(PG8_SB(0, 1), b2 + hstepB, voffB);
            PG8_WAIT_V(6); PG8_BAR; PG8_MMA(1, 1, At, B1); PG8_BAR;
            PG8_LDB(B0, 1, 0); PG8_SCHED; PG8_LDA(At, 1, 0); PG8_STAGE(PG8_SA(0, 1), a2 + hstepA, voffA);
            PG8_WAIT_L(8); PG8_BAR; PG8_WAIT_L(0); PG8_MMA(0, 0, At, B0); PG8_BAR; PG8_SCHED;
            PG8_LDB(B1, 1, 1); PG8_STAGE(PG8_SB(1, 0), b3, voffB);
            PG8_BAR; PG8_WAIT_L(0); PG8_MMA(0, 1, At, B1); PG8_BAR;
            PG8_LDA(At, 1, 1); PG8_STAGE(PG8_SA(1, 0), a3, voffA);
            PG8_BAR; PG8_WAIT_L(0); PG8_MMA(1, 0, At, B0); PG8_BAR; PG8_SCHED;
            PG8_STAGE(PG8_SB(1, 1), b3 + hstepB, voffB);
            PG8_WAIT_V(6); PG8_BAR; PG8_MMA(1, 1, At, B1); PG8_BAR;
            }
        }
        if constexpr (ALIGN_EPI) { if (wr == 0) PG8_BAR; }
        if constexpr (!Epi::AFTER_DRAIN) { E(acc, cur, wr, wc, fr, fq); S.done(cur); }
        if (!has_next) break;
#pragma unroll
        for (int a = 0; a < 2; ++a)
#pragma unroll
            for (int b = 0; b < 2; ++b)
#pragma unroll
                for (int m = 0; m < 4; ++m)
#pragma unroll
                    for (int n = 0; n < 2; ++n) acc[a][b][m][n] = (f32x4){0.f, 0.f, 0.f, 0.f};
        cur = nxt; cA = nA; cB = nB; ++ui;
        if constexpr (ALIGN_EPI) { if (wr == 1) PG8_BAR; }
    }
    PG8_WAIT_V(0);
    if constexpr (!ALIGN_EPI) { if (wr == 0) PG8_BAR; }
    PG8_BAR;
    if constexpr (Epi::AFTER_DRAIN) { E.fused(acc, cur, wr, wc, fr, fq, lds, wid, lane); S.done(cur); }
#undef PG8_SA
#undef PG8_SB
#undef PG8_STAGE
#undef PG8_LDA
#undef PG8_LDB
#undef PG8_MMA
#undef PG8_WAIT_V
#undef PG8_WAIT_L
#undef PG8_BAR
#undef PG8_SCHED
}
}

constexpr int DM = 2048, NB = 16, TL = 2048, TCX = 256, DEPTH = 4;
constexpr int ROWS_C = NB * TCX, ROWS_L = NB * TL, M_ALL = ROWS_C + ROWS_L;
constexpr int NMODC = 6 * DM;
constexpr int HG_N = 5 * DM;
constexpr int GDN_N = 12416, GDN_NP = 12544;
constexpr int NA_N = 3 * DM;
constexpr int DFF = 5504, UP_N = 2 * DFF;
constexpr float RMS_EPS = 1e-6f;
constexpr int NWAVES = 8, NTHREADS = 512;

constexpr size_t MiB = (size_t)1 << 20;
constexpr size_t WS_CTL = 0, CTL_ZERO_BYTES = 1 * MiB;
constexpr size_t WS_MOD = 1 * MiB;
constexpr size_t WS_CTXR = 5 * MiB;
constexpr size_t WS_WT_IN = 37 * MiB;
constexpr size_t WS_WT_OUT = 86 * MiB;
constexpr size_t WS_WT_UP = 102 * MiB;
constexpr size_t WS_WT_DN = 145 * MiB;
constexpr size_t WS_P = 167 * MiB;
constexpr size_t WS_O = 1049 * MiB;
constexpr size_t WS_H = 1337 * MiB;
constexpr size_t WS_END = 1481 * MiB;
constexpr int CW_BAR = 4096;

constexpr int LDS_BYTES = 163840;
constexpr int MISC_OFF = LDS_BYTES - 256;

#define GAS __attribute__((address_space(1)))
#define LAS __attribute__((address_space(3)))
typedef unsigned short bf16;
typedef unsigned v4u __attribute__((ext_vector_type(4)));
typedef unsigned v2u __attribute__((ext_vector_type(2)));
typedef float f32x4 __attribute__((ext_vector_type(4)));
typedef GAS const float* gcf;
typedef GAS float* gf;
typedef GAS const bf16* gcb;
typedef GAS bf16* gb;
#define LDS_WAIT() asm volatile("s_waitcnt lgkmcnt(0)" ::: "memory")
#define VM_WAIT() asm volatile("s_waitcnt vmcnt(0)" ::: "memory")
#define LDS_BARRIER() do { asm volatile("s_waitcnt lgkmcnt(0)" ::: "memory"); __builtin_amdgcn_s_barrier(); asm volatile("" ::: "memory"); } while (0)
typedef float f32x2_t __attribute__((ext_vector_type(2)));
typedef __bf16 bf16x2_t __attribute__((ext_vector_type(2)));
__device__ __forceinline__ unsigned pk2(float lo, float hi) { const f32x2_t v = {lo, hi}; return __builtin_bit_cast(unsigned, __builtin_convertvector(v, bf16x2_t)); }
__device__ __forceinline__ unsigned f2bf(float f) { return pk2(f, 0.f) & 0xffffu; }
__device__ __forceinline__ float bflo(unsigned u) { return __builtin_bit_cast(float, u << 16); }
__device__ __forceinline__ float bfhi(unsigned u) { return __builtin_bit_cast(float, u & 0xffff0000u); }
__device__ __forceinline__ float bf2f(bf16 b) { return __builtin_bit_cast(float, (unsigned)b << 16); }
__device__ __forceinline__ float silu_f(float x) { return x * __builtin_amdgcn_rcpf(1.f + __expf(-x)); }
__device__ __forceinline__ float sigmoid_f(float x) { return __builtin_amdgcn_rcpf(1.f + __expf(-x)); }
template <int CTRL> __device__ __forceinline__ float dppf(float x) { return __builtin_bit_cast(float, __builtin_amdgcn_mov_dpp(__builtin_bit_cast(int, x), CTRL, 0xf, 0xf, true)); }
__device__ __forceinline__ float sum8(float x) { x += dppf<0xB1>(x); x += dppf<0x4E>(x); x += dppf<0x141>(x); return x; }
__device__ __forceinline__ float max8(float x) { x = fmaxf(x, dppf<0xB1>(x)); x = fmaxf(x, dppf<0x4E>(x)); x = fmaxf(x, dppf<0x141>(x)); return x; }
__device__ __forceinline__ float sum16(float x) { x = sum8(x); x += dppf<0x128>(x); return x; }
__device__ __forceinline__ float sum32(float x) { x = sum16(x); auto s = __builtin_amdgcn_permlane16_swap(__float_as_uint(x), __float_as_uint(x), false, false); return __uint_as_float(s[0]) + __uint_as_float(s[1]); }
__device__ __forceinline__ float wave_sum(float x) { x = sum32(x); auto t = __builtin_amdgcn_permlane32_swap(__float_as_uint(x), __float_as_uint(x), false, false); return __uint_as_float(t[0]) + __uint_as_float(t[1]); }

#define XB_TMO      128
#define XB_XCNT(j)  (256  + 64 * (j))
#define XB_XSUB(j)  (1280 + 64 * (j))
#define XB_XGEN(j)  (2304 + 64 * (j))
#define XB_TOP      3328
#define XB_TOPGEN   3392
#define XCD_BAR_WORDS 3456
#define XB_SPIN_CAP (1u << 18)
__device__ __forceinline__ unsigned xb_ld(unsigned* p)              { return __hip_atomic_load(p, __ATOMIC_RELAXED, __HIP_MEMORY_SCOPE_AGENT); }
__device__ __forceinline__ unsigned xb_add(unsigned* p, unsigned v) { return __hip_atomic_fetch_add(p, v, __ATOMIC_RELAXED, __HIP_MEMORY_SCOPE_AGENT); }
__device__ __forceinline__ unsigned xb_xcc_id() { return (unsigned)__builtin_amdgcn_s_getreg((3 << 11) | 20) & 0xFu; }
#define XB_SPIN(cond, bar) do { unsigned _sp = 0; while (cond) { __builtin_amdgcn_s_sleep(1); \
    if ((++_sp & 255u) == 0u) { if (xb_ld(&(bar)[XB_TMO])) break; if (_sp > XB_SPIN_CAP) { atomicAdd(&(bar)[XB_TMO], 1u); break; } } } } while (0)
struct XcdBarrier { unsigned* bar; unsigned x; volatile LAS unsigned* st; };
__device__ __forceinline__ XcdBarrier xcd_barrier_post(unsigned* bar, volatile LAS unsigned* st, const int tid) {
    XcdBarrier b; b.bar = bar; b.x = xb_xcc_id(); b.st = st;
    if (tid == 0) (void)xb_add(&bar[XB_XCNT(b.x)], 1u);
    return b;
}
__device__ __forceinline__ void xcd_barrier_complete(unsigned* bar, unsigned x, unsigned& nloc, unsigned& nx) {
    const unsigned G = gridDim.x * gridDim.y * gridDim.z;
    unsigned sum, cnt, mine, sp = 0u;
    for (;;) {
        sum = 0u; cnt = 0u; mine = 0u;
#pragma unroll
        for (unsigned j = 0; j < 16; ++j) { const unsigned c = xb_ld(&bar[XB_XCNT(j)]); sum += c; cnt += (c > 0u) ? 1u : 0u; mine = (j == x) ? c : mine; }
        if (sum == G) break;
        __builtin_amdgcn_s_sleep(1);
        if ((++sp & 255u) == 0u) { if (xb_ld(&bar[XB_TMO])) break; if (sp > XB_SPIN_CAP) { atomicAdd(&bar[XB_TMO], 1u); break; } }
    }
    nloc = mine > 0u ? mine : 1u; nx = cnt > 0u ? cnt : 1u;
}
__device__ __forceinline__ void xcd_barrier(const XcdBarrier& b, const int tid) {
    asm volatile("s_waitcnt vmcnt(0)" ::: "memory");
    __syncthreads();
    if (tid == 0) {
        unsigned* bar = b.bar;
        __builtin_amdgcn_s_waitcnt(0);
        unsigned nloc = b.st[0], nx = b.st[1];
        if (nloc == 0u) { xcd_barrier_complete(bar, b.x, nloc, nx); b.st[0] = nloc; b.st[1] = nx; }
        const unsigned old = xb_add(&bar[XB_XSUB(b.x)], 1u);
        const unsigned gen = old / nloc;
        if (old + 1u == (gen + 1u) * nloc) {
            __builtin_amdgcn_fence(__ATOMIC_RELEASE, "agent");
            asm volatile("s_waitcnt vmcnt(0)" ::: "memory");
            const unsigned og = xb_add(&bar[XB_TOP], 1u);
            const unsigned tg = og / nx;
            if (og + 1u == (tg + 1u) * nx) xb_add(&bar[XB_TOPGEN], 1u);
            else XB_SPIN(xb_ld(&bar[XB_TOPGEN]) == tg, bar);
            __builtin_amdgcn_fence(__ATOMIC_ACQUIRE, "agent");
            xb_add(&bar[XB_XGEN(b.x)], 1u);
            asm volatile("s_waitcnt vmcnt(0)" ::: "memory");
        } else {
            XB_SPIN(xb_ld(&bar[XB_XGEN(b.x)]) == gen, bar);
            __builtin_amdgcn_fence(__ATOMIC_ACQUIRE, "agent");
            asm volatile("s_waitcnt vmcnt(0)" ::: "memory");
        }
    }
    __syncthreads();
}

struct Args { const float* in[26]; float* out; unsigned char* ws; int ph_lo, ph_hi; };
enum { I_X = 0, I_C, I_CTX, I_CCTX, I_ADAW, I_ADAB, I_NMG, I_NFG, I_HGWIN, I_HGLB, I_HGNG, I_HGWOUT, I_GDNWIN, I_GDNCW, I_GDNALOG, I_GDNDTB, I_GDNNG, I_GDNWOUT,
       I_NAWQKV, I_NAQG, I_NAKG, I_NARPB, I_NAWOUT, I_FFNUP, I_FFNCW, I_FFNDN };
#define FRAME_TID(F) do { (F).lane = pg8::lane_id_asm(); (F).tid = (F).wave * 64 + (F).lane; } while (0)
struct Frame {
    LAS unsigned char* lds;
    int tid, lane, wave, G, gw, NGW;
    gcf in[26];
    gf out;
    GAS unsigned char* ws;
};

__device__ __forceinline__ void transpose_item(gcf W, int K, int N, gb WT, LAS float* scr, int item, int lane, bool perm_up = false) {
    const int nblk = N / 64, kb = item / nblk, nb = item % nblk, k0 = 64 * kb, n0 = 64 * nb;
    int nr0 = n0; if (perm_up) { const int half = n0 / DFF, jx = n0 - half * DFF; nr0 = (jx >> 7) * 256 + half * 128 + (jx & 127); }
#pragma unroll
    for (int hb = 0; hb < 2; ++hb) {
        float wv[32];
#pragma unroll
        for (int i = 0; i < 32; ++i) wv[i] = W[(size_t)(k0 + hb * 32 + i) * N + n0 + lane];
#pragma unroll
        for (int i = 0; i < 32; ++i) scr[(hb * 32 + i) * 65 + lane] = wv[i];
    }
    LDS_WAIT(); asm volatile("" ::: "memory");
    const int c = lane & 7;
#pragma unroll
    for (int j = 0; j < 8; ++j) { const int n = (lane >> 3) + 8 * j; const LAS float* s = scr + (8 * c) * 65 + n;
        v4u o; o.x = pk2(s[0 * 65], s[1 * 65]); o.y = pk2(s[2 * 65], s[3 * 65]); o.z = pk2(s[4 * 65], s[5 * 65]); o.w = pk2(s[6 * 65], s[7 * 65]);
        *(GAS v4u*)(WT + (size_t)(nr0 + n) * K + k0 + 8 * c) = o; }
    LDS_WAIT(); asm volatile("" ::: "memory");
}

__device__ __forceinline__ void phase_mod(Frame& F) {
    FRAME_TID(F);
    LAS float* red = (LAS float*)F.lds;
    gf mod = (gf)(F.ws + WS_MOD);
    const int w = F.wave;
    for (int item = blockIdx.x; item < (4 * NMODC) / 192; item += F.G) {
        int lane = F.lane; asm volatile("" : "+v"(lane));
        const int j = lane & 15, kq = lane >> 4;
        const int col0 = item * 192, i = col0 / NMODC, n0 = col0 - i * NMODC;
        gcf wp = F.in[I_ADAW] + ((size_t)i * 2048 + w * 256 + 4 * kq) * NMODC + n0 + 4 * j;
        gcf cp = F.in[I_C] + j * 2048 + w * 256 + 4 * kq;
        gcf xp = F.in[I_CCTX] + w * 256 + 4 * kq;
        f32x4 acc[3][4], a16[3];
#pragma unroll
        for (int g = 0; g < 3; ++g) { a16[g] = (f32x4){0.f, 0.f, 0.f, 0.f};
#pragma unroll
            for (int t = 0; t < 4; ++t) acc[g][t] = (f32x4){0.f, 0.f, 0.f, 0.f}; }
#pragma unroll 2
        for (int kk = 0; kk < 16; ++kk) {
            const f32x4 cv = *(const GAS f32x4*)(cp + kk * 16), xv = *(const GAS f32x4*)(xp + kk * 16);
            f32x4 sa, sx;
#pragma unroll
            for (int e = 0; e < 4; ++e) { sa[e] = silu_f(cv[e]); sx[e] = silu_f(xv[e]); }
#pragma unroll
            for (int e = 0; e < 4; ++e)
#pragma unroll
                for (int g = 0; g < 3; ++g) {
                    const f32x4 wv = *(const GAS f32x4*)(wp + (size_t)(kk * 16 + e) * NMODC + g * 64);
#pragma unroll
                    for (int t = 0; t < 4; ++t) acc[g][t] = __builtin_amdgcn_mfma_f32_16x16x4f32(sa[e], wv[t], acc[g][t], 0, 0, 0);
                    a16[g] = a16[g] + wv * sx[e];
                }
        }
#pragma unroll
        for (int g = 0; g < 3; ++g) {
#pragma unroll
            for (int r = 0; r < 4; ++r) *(LAS f32x4*)(red + (w * 17 + 4 * kq + r) * 192 + 64 * g + 4 * j) = (f32x4){acc[g][0][r], acc[g][1][r], acc[g][2][r], acc[g][3][r]};
            f32x4 s = a16[g];
#pragma unroll
            for (int t = 0; t < 4; ++t) { float x = s[t];
                { auto p = __builtin_amdgcn_permlane16_swap(__float_as_uint(x), __float_as_uint(x), false, false); x = __uint_as_float(p[0]) + __uint_as_float(p[1]); }
                { auto p = __builtin_amdgcn_permlane32_swap(__float_as_uint(x), __float_as_uint(x), false, false); x = __uint_as_float(p[0]) + __uint_as_float(p[1]); }
                s[t] = x; }
            if (kq == 0) *(LAS f32x4*)(red + (w * 17 + 16) * 192 + 64 * g + 4 * j) = s;
        }
        __syncthreads();
        for (int idx = F.tid; idx < 17 * 192; idx += NTHREADS) { const int r = idx / 192, c = idx - r * 192;
            float v = F.in[I_ADAB][i * NMODC + n0 + c];
#pragma unroll
            for (int ww = 0; ww < 8; ++ww) v += red[(ww * 17 + r) * 192 + c];
            mod[((size_t)i * 17 + r) * NMODC + n0 + c] = v; }
        __syncthreads();
    }
}

__device__ __forceinline__ void phase_wprep(Frame& F, int L) {
    FRAME_TID(F);
    const int m = L % 3, j = L / 3;
    LAS float* scr = (LAS float*)(F.lds + F.wave * 16896);
    gcf Win = (m == 0) ? F.in[I_HGWIN] + (size_t)j * DM * HG_N : (m == 1) ? F.in[I_GDNWIN] : F.in[I_NAWQKV];
    const int Nin = (m == 0) ? HG_N : (m == 1) ? GDN_N : NA_N;
    gcf Wout = (m == 0) ? F.in[I_HGWOUT] + (size_t)j * DM * DM : (m == 1) ? F.in[I_GDNWOUT] : F.in[I_NAWOUT];
    const int Kout = (m == 1) ? 2 * DM : DM;
    gcf Wup = F.in[I_FFNUP] + (size_t)L * DM * UP_N;
    gcf Wdn = F.in[I_FFNDN] + (size_t)L * DFF * DM;
    gb Tin = (gb)(F.ws + WS_WT_IN), Tout = (gb)(F.ws + WS_WT_OUT), Tup = (gb)(F.ws + WS_WT_UP), Tdn = (gb)(F.ws + WS_WT_DN);
    const int I_in = (DM / 64) * (Nin / 64), I_out = (Kout / 64) * (DM / 64), I_up = (DM / 64) * (UP_N / 64), I_dn = (DFF / 64) * (DM / 64);
    const int total = I_in + I_out + I_up + I_dn;
    for (int it = F.gw; it < total; it += F.NGW) {
        int r = it;
        if (r < I_in) { transpose_item(Win, DM, Nin, Tin, scr, r, F.lane); continue; } r -= I_in;
        if (r < I_out) { transpose_item(Wout, Kout, DM, Tout, scr, r, F.lane); continue; } r -= I_out;
        if (r < I_up) { transpose_item(Wup, DM, UP_N, Tup, scr, r, F.lane, true); continue; } r -= I_up;
        transpose_item(Wdn, DFF, DM, Tdn, scr, r, F.lane);
    }
    if (m == 1) {
        GAS v4u* z = (GAS v4u*)(Tin + (size_t)GDN_N * DM);
        const int n16 = (GDN_NP - GDN_N) * DM * 2 / 16;
        for (int i = blockIdx.x * NTHREADS + F.tid; i < n16; i += F.G * NTHREADS) z[i] = (v4u){0u, 0u, 0u, 0u};
    }
}

template <bool IN16> __device__ __forceinline__ void phase_norm(Frame& F, gcf gvec, gcf modL, int chunk, gcf xlat, gcf xctx, GAS const _Float16* x16, int row_lo, int row_hi) {
    FRAME_TID(F);
    gb H = (gb)(F.ws + WS_H);
    const int nrows = row_hi - row_lo, rpw = (nrows + F.NGW - 1) / F.NGW;
    const int r0 = row_lo + F.gw * rpw, r1 = (r0 + rpw < row_hi) ? r0 + rpw : row_hi;
    int cur = -1; f32x4 Av[8], Bv[8];
    for (int r = r0; r < r1; ++r) {
        const int mr = (r < ROWS_C) ? 16 : ((r - ROWS_C) >> 11);
        if (mr != cur) { cur = mr;
#pragma unroll
            for (int jj = 0; jj < 8; ++jj) { const int c = (F.lane + 64 * jj) * 4;
                const f32x4 g4 = *(GAS const f32x4*)(gvec + c), sc = *(GAS const f32x4*)(modL + (size_t)mr * NMODC + (chunk + 1) * DM + c), sh = *(GAS const f32x4*)(modL + (size_t)mr * NMODC + chunk * DM + c);
                Av[jj] = g4 * (sc + 1.0f); Bv[jj] = sh; } }
        f32x4 v[8]; float ss = 0.f;
        if constexpr (IN16) {
            typedef _Float16 h4_t __attribute__((ext_vector_type(4)));
            GAS const _Float16* xr = x16 + (size_t)r * DM;
            h4_t hv[8];
#pragma unroll
            for (int jj = 0; jj < 8; ++jj) hv[jj] = *(GAS const h4_t*)(xr + (F.lane + 64 * jj) * 4);
#pragma unroll
            for (int jj = 0; jj < 8; ++jj) v[jj] = __builtin_convertvector(hv[jj], f32x4);
        } else {
            gcf xr = (r < ROWS_C) ? xctx + (size_t)r * DM : xlat + (size_t)(r - ROWS_C) * DM;
#pragma unroll
            for (int jj = 0; jj < 8; ++jj) v[jj] = *(GAS const f32x4*)(xr + (F.lane + 64 * jj) * 4);
        }
#pragma unroll
        for (int jj = 0; jj < 8; ++jj) ss += (v[jj].x * v[jj].x + v[jj].y * v[jj].y) + (v[jj].z * v[jj].z + v[jj].w * v[jj].w);
        const float rstd = __builtin_amdgcn_rsqf(wave_sum(ss) * (1.f / DM) + RMS_EPS);
        GAS v2u* o = (GAS v2u*)(H + (size_t)r * DM);
#pragma unroll
        for (int jj = 0; jj < 8; ++jj) { const f32x4 y = v[jj] * rstd * Av[jj] + Bv[jj]; o[F.lane + 64 * jj] = (v2u){pk2(y.x, y.y), pk2(y.z, y.w)}; }
    }
}

__device__ __forceinline__ void phase_ffnfix(Frame& F, int L, int row_lo, int row_hi) {
    FRAME_TID(F);
    gcb SIDE = (gcb)(F.ws + WS_WT_IN); gb Gt = (gb)(F.ws + WS_P);   gcf cw = F.in[I_FFNCW] + (size_t)L * 3 * UP_N;
    const int s_lo = row_lo / 64, s_hi = row_hi / 64;
    const int nitems = (s_hi - s_lo) * 2 * (DFF / 8);
    for (int it = blockIdx.x * NTHREADS + F.tid; it < nitems; it += F.G * NTHREADS) {
        const int cg = it % (DFF / 8), rs = it / (DFF / 8), s = s_lo + (rs >> 1), last = rs & 1;
        const int row = s * 64 + (last ? 63 : 0);
        const int sl = (row < ROWS_C) ? (row & 255) : ((row - ROWS_C) & 2047), slen = (row < ROWS_C) ? TCX : TL;
        const int jg = cg * 8, np = (jg >> 7) * 256 + (jg & 127);
        gcb pprev = last ? (SIDE + ((size_t)s * 4 + 2) * UP_N) : (SIDE + ((size_t)(s - 1) * 4 + 3) * UP_N);
        gcb pcur = SIDE + ((size_t)s * 4 + (last ? 3 : 0)) * UP_N;
        gcb pnext = last ? (SIDE + ((size_t)(s + 1) * 4 + 0) * UP_N) : (SIDE + ((size_t)s * 4 + 1) * UP_N);
        const bool has_prev = last || sl > 0, has_next = !last || (sl + 1) < slen;
        const v4u z4 = (v4u){0u, 0u, 0u, 0u};
        const v4u pa = has_prev ? *(GAS const v4u*)(pprev + np) : z4, pb = has_prev ? *(GAS const v4u*)(pprev + np + 128) : z4;
        const v4u ca = *(GAS const v4u*)(pcur + np), cb = *(GAS const v4u*)(pcur + np + 128);
        const v4u na = has_next ? *(GAS const v4u*)(pnext + np) : z4, nb = has_next ? *(GAS const v4u*)(pnext + np + 128) : z4;
        float wta[3][8], wtb[3][8];
#pragma unroll
        for (int t = 0; t < 3; ++t) { const f32x4 a0 = *(GAS const f32x4*)(cw + t * UP_N + jg), a1 = *(GAS const f32x4*)(cw + t * UP_N + jg + 4), b0 = *(GAS const f32x4*)(cw + t * UP_N + DFF + jg), b1 = *(GAS const f32x4*)(cw + t * UP_N + DFF + jg + 4);
            wta[t][0] = a0.x; wta[t][1] = a0.y; wta[t][2] = a0.z; wta[t][3] = a0.w; wta[t][4] = a1.x; wta[t][5] = a1.y; wta[t][6] = a1.z; wta[t][7] = a1.w;
            wtb[t][0] = b0.x; wtb[t][1] = b0.y; wtb[t][2] = b0.z; wtb[t][3] = b0.w; wtb[t][4] = b1.x; wtb[t][5] = b1.y; wtb[t][6] = b1.z; wtb[t][7] = b1.w; }
        float g[8];
#pragma unroll
        for (int e = 0; e < 8; ++e) {
            const unsigned wpa = (e < 2) ? pa.x : (e < 4) ? pa.y : (e < 6) ? pa.z : pa.w, wca = (e < 2) ? ca.x : (e < 4) ? ca.y : (e < 6) ? ca.z : ca.w, wna = (e < 2) ? na.x : (e < 4) ? na.y : (e < 6) ? na.z : na.w;
            const unsigned wpb = (e < 2) ? pb.x : (e < 4) ? pb.y : (e < 6) ? pb.z : pb.w, wcb = (e < 2) ? cb.x : (e < 4) ? cb.y : (e < 6) ? cb.z : cb.w, wnb = (e < 2) ? nb.x : (e < 4) ? nb.y : (e < 6) ? nb.z : nb.w;
            const float ap = (e & 1) ? bfhi(wpa) : bflo(wpa), ac = (e & 1) ? bfhi(wca) : bflo(wca), an = (e & 1) ? bfhi(wna) : bflo(wna);
            const float bp = (e & 1) ? bfhi(wpb) : bflo(wpb), bc = (e & 1) ? bfhi(wcb) : bflo(wcb), bn = (e & 1) ? bfhi(wnb) : bflo(wnb);
            const float a = ap * wta[0][e] + ac * wta[1][e] + an * wta[2][e];
            const float b = bp * wtb[0][e] + bc * wtb[1][e] + bn * wtb[2][e];
            g[e] = silu_f(a) * b;
        }
        *(GAS v4u*)(Gt + (size_t)row * DFF + jg) = (v4u){pk2(g[0], g[1]), pk2(g[2], g[3]), pk2(g[4], g[5]), pk2(g[6], g[7])};
    }
}

typedef short hb8 __attribute__((ext_vector_type(8)));
typedef short hb4 __attribute__((ext_vector_type(4)));
typedef float v2f __attribute__((ext_vector_type(2)));
#define MFMA16(a, b, c) __builtin_amdgcn_mfma_f32_16x16x32_bf16((a), (b), (c), 0, 0, 0)
constexpr int HQS = 144, HTS = 80, HOS = 132;
constexpr int HG_QT = 0, HG_KT = 18432, HG_KTT = 36864, HG_VT = 57344, HG_ATT = 77824, HG_SB = 88064, HG_ER = 124928, HG_EEND = 125440, HG_SEG = 125952;
__device__ __forceinline__ int hg_row(int b, int d, int pos) {
    return (pos < TCX) ? (b * TCX + (d ? (TCX - 1 - pos) : pos)) : (ROWS_C + b * TL + (d ? (TL - 1 - (pos - TCX)) : (pos - TCX)));
}
__device__ __forceinline__ void phase_hg2(Frame& F, int j, bool ctx_out, bool dry = false) {
    FRAME_TID(F);
    gb P = (gb)(F.ws + WS_P); gb OF = (gb)(F.ws + WS_O);
    gcf lbl = F.in[I_HGLB]; gcf ng = F.in[I_HGNG] + j * 128;
    LAS bf16* Qt = (LAS bf16*)(F.lds + HG_QT); LAS bf16* Kt = (LAS bf16*)(F.lds + HG_KT); LAS bf16* KtT = (LAS bf16*)(F.lds + HG_KTT); LAS bf16* VT = (LAS bf16*)(F.lds + HG_VT);
    LAS bf16* ATT = (LAS bf16*)(F.lds + HG_ATT); LAS bf16* SB = (LAS bf16*)(F.lds + HG_SB);
    LAS float* er = (LAS float*)(F.lds + HG_ER); LAS float* eend = (LAS float*)(F.lds + HG_EEND); LAS float* segs = (LAS float*)(F.lds + HG_SEG);
    LAS float* s_ng = (LAS float*)(F.lds + 131072);
    LAS float* O32 = (LAS float*)(F.lds + HG_QT);
    const int c2_ = F.tid & 63, seg_ = F.tid >> 6;
    const int l15_ = F.lane & 15, q4_ = F.lane >> 4, vb = F.wave;
    const int rt = F.tid >> 3, g8 = F.tid & 7;
    for (int item = blockIdx.x; item < NB * 16; item += F.G) {
        const int b = item >> 4, h = item & 15;
        if (F.tid < 128) s_ng[F.tid] = ng[F.tid];
        for (int d = 0; d < 2; ++d) {
            float lb0, lb1;
            { const int cc = 2 * c2_;
              const float a0 = lbl[(0 * 2 + d) * DM + h * 128 + cc], a1 = lbl[(1 * 2 + d) * DM + h * 128 + cc], b0 = lbl[(0 * 2 + d) * DM + h * 128 + cc + 1], b1 = lbl[(1 * 2 + d) * DM + h * 128 + cc + 1];
              const float mx = fmaxf(a0, a1), e0 = __expf(a0 - mx), e1 = __expf(a1 - mx), my = fmaxf(b0, b1), f0 = __expf(b0 - my), f1 = __expf(b1 - my);
              lb0 = (j == 0) ? 0.f : e1 / (e0 + e1); lb1 = (j == 0) ? 0.f : f1 / (f0 + f1); }
            f32x4 S[8];
#pragma unroll
            for (int kt = 0; kt < 8; ++kt) S[kt] = (f32x4){0.f, 0.f, 0.f, 0.f};
            unsigned rq[8], rf[8], rv[8];
            {
                gcb pr = P + h * 128 + 2 * c2_;
#pragma unroll
                for (int i = 0; i < 8; ++i) { const size_t ro = (size_t)hg_row(b, d, seg_ * 8 + i) * HG_N; rq[i] = *(GAS const unsigned*)(pr + ro); rv[i] = *(GAS const unsigned*)(pr + ro + DM); rf[i] = *(GAS const unsigned*)(pr + ro + (2 + d) * DM); }
            }
#pragma unroll 1
            for (int ch = 0; ch < (TCX + TL) / 64; ++ch) {
                const int s0 = ch * 64;
                int c2 = c2_, l15 = l15_, q4 = q4_; asm volatile("" : "+v"(c2), "+v"(l15), "+v"(q4)); const int seg = vb;
                LDS_BARRIER();
                unsigned kp[8]; float pr0[8], pr1[8]; float tot0 = 1.f, tot1 = 1.f;
                {
                    float f0[8], f1[8];
#pragma unroll
                    for (int i = 0; i < 8; ++i) {
                        const float xf0 = bflo(rf[i]), xf1 = bfhi(rf[i]);
                        const float ex0 = __expf(-fabsf(xf0)), rc0 = __builtin_amdgcn_rcpf(1.f + ex0), ex1 = __expf(-fabsf(xf1)), rc1 = __builtin_amdgcn_rcpf(1.f + ex1);
                        const float sp0 = (xf0 >= 0.f) ? rc0 : ex0 * rc0, sn0 = (xf0 >= 0.f) ? ex0 * rc0 : rc0, sp1 = (xf1 >= 0.f) ? rc1 : ex1 * rc1, sn1 = (xf1 >= 0.f) ? ex1 * rc1 : rc1;
                        kp[i] = pk2((1.f - lb0) * sn0, (1.f - lb1) * sn1);
                        f0[i] = fmaxf(lb0 + (1.f - lb0) * sp0, 1e-30f); f1[i] = fmaxf(lb1 + (1.f - lb1) * sp1, 1e-30f);
                    }
                    if (seg >= 4) {
#pragma unroll
                        for (int i = 0; i < 8; ++i) { tot0 = fmaxf(tot0 * f0[i], 1e-30f); tot1 = fmaxf(tot1 * f1[i], 1e-30f); pr0[i] = tot0; pr1[i] = tot1; }
                    } else {
#pragma unroll
                        for (int i = 7; i >= 0; --i) { pr0[i] = tot0; pr1[i] = tot1; tot0 = fmaxf(tot0 * f0[i], 1e-30f); tot1 = fmaxf(tot1 * f1[i], 1e-30f); }
                    }
                }
                *(LAS v2f*)(segs + seg * 128 + 2 * c2) = (v2f){tot0, tot1};
                {
                    const v4u w0 = (v4u){(rv[0] & 0xffffu) | (rv[1] << 16), (rv[2] & 0xffffu) | (rv[3] << 16), (rv[4] & 0xffffu) | (rv[5] << 16), (rv[6] & 0xffffu) | (rv[7] << 16)};
                    const v4u w1 = (v4u){(rv[0] >> 16) | (rv[1] & 0xffff0000u), (rv[2] >> 16) | (rv[3] & 0xffff0000u), (rv[4] >> 16) | (rv[5] & 0xffff0000u), (rv[6] >> 16) | (rv[7] & 0xffff0000u)};
                    *(LAS v4u*)(VT + (2 * c2) * HTS + seg * 8) = w0; *(LAS v4u*)(VT + (2 * c2 + 1) * HTS + seg * 8) = w1;
                }
                unsigned qp[8];
#pragma unroll
                for (int i = 0; i < 8; ++i) qp[i] = rq[i];
                int rto = rt, g8o = g8; asm volatile("" : "+v"(rto), "+v"(g8o));
                const int rrow = hg_row(b, d, s0 + rto);
                const bool do_out = (d == 1) && !dry && (ctx_out || s0 >= TCX);
                v4u pf[2], pg[2];
                { const int lrow = do_out ? rrow : 0;
                    const unsigned fo = ((unsigned)lrow * DM + g8o * 16) * 2u, go = ((unsigned)lrow * HG_N + g8o * 16) * 2u;
                    GAS const char* ofb = (GAS const char*)(OF + h * 128); GAS const char* gb_ = (GAS const char*)(P + 4 * DM + h * 128);
                    pf[0] = *(GAS const v4u*)(ofb + fo); pf[1] = *(GAS const v4u*)(ofb + fo + 16); pg[0] = *(GAS const v4u*)(gb_ + go); pg[1] = *(GAS const v4u*)(gb_ + go + 16); }
                {
                    const int s0n = (ch + 1 < (TCX + TL) / 64) ? s0 + 64 : s0;
                    GAS const char* ub = (GAS const char*)(P + h * 128 + (size_t)hg_row(b, d, s0n + seg * 8) * HG_N);
                    const long stpb = d ? -(long)HG_N * 2 : (long)HG_N * 2;
                    const unsigned vo = 4u * (unsigned)c2;
                    const unsigned vo1 = vo + DM * 2, vo2 = vo + (2 + d) * DM * 2;
#pragma unroll
                    for (int i = 0; i < 8; ++i) { GAS const char* ui = ub + i * stpb; rq[i] = *(GAS const unsigned*)(ui + vo); rv[i] = *(GAS const unsigned*)(ui + vo1); rf[i] = *(GAS const unsigned*)(ui + vo2); }
                }
                LDS_BARRIER();
                float m0 = 1.f, m1 = 1.f, er0 = 1.f, er1 = 1.f, en0 = 1.f, en1 = 1.f;
#pragma unroll
                for (int sg = 0; sg < 8; ++sg) { const v2f g = *(const LAS v2f*)(segs + sg * 128 + 2 * c2);
                    if (sg < 4) { er0 = fmaxf(er0 * g.x, 1e-30f); er1 = fmaxf(er1 * g.y, 1e-30f); } else { en0 = fmaxf(en0 * g.x, 1e-30f); en1 = fmaxf(en1 * g.y, 1e-30f); }
                    const bool inm = (seg >= 4) ? (sg >= 4 && sg < seg) : (sg > seg && sg < 4);
                    if (inm) { m0 = fmaxf(m0 * g.x, 1e-30f); m1 = fmaxf(m1 * g.y, 1e-30f); } }
                if (seg == 0) { *(LAS v2f*)(er + 2 * c2) = (v2f){er0, er1}; *(LAS v2f*)(eend + 2 * c2) = (v2f){en0, en1}; }
                {
                    unsigned k0[8], k1[8];
#pragma unroll
                    for (int i = 0; i < 8; ++i) { const int t = seg * 8 + i;
                        const float small0 = fmaxf(m0 * pr0[i], 1e-30f), small1 = fmaxf(m1 * pr1[i], 1e-30f);
                        const float big0 = __builtin_amdgcn_rcpf(small0), big1 = __builtin_amdgcn_rcpf(small1);
                        const float eq0 = (seg >= 4) ? small0 : big0, eq1 = (seg >= 4) ? small1 : big1, ek0 = (seg >= 4) ? big0 : small0, ek1 = (seg >= 4) ? big1 : small1;
                        *(LAS unsigned*)(Qt + t * HQS + 2 * c2) = pk2(bflo(qp[i]) * eq0, bfhi(qp[i]) * eq1);
                        const unsigned kk2 = pk2(bflo(kp[i]) * ek0, bfhi(kp[i]) * ek1);
                        k0[i] = kk2 & 0xffffu; k1[i] = kk2 >> 16;
                        *(LAS unsigned*)(Kt + t * HQS + 2 * c2) = kk2; }
                    *(LAS v4u*)(KtT + (2 * c2) * HTS + seg * 8) = (v4u){k0[0] | (k0[1] << 16), k0[2] | (k0[3] << 16), k0[4] | (k0[5] << 16), k0[6] | (k0[7] << 16)};
                    *(LAS v4u*)(KtT + (2 * c2 + 1) * HTS + seg * 8) = (v4u){k1[0] | (k1[1] << 16), k1[2] | (k1[3] << 16), k1[4] | (k1[5] << 16), k1[6] | (k1[7] << 16)};
                }
                LDS_BARRIER();
#pragma unroll
                for (int kt = 0; kt < 8; ++kt) { const f32x4 e4 = *(const LAS f32x4*)(er + kt * 16 + q4 * 4); S[kt] = S[kt] * e4; }
#pragma unroll
                for (int tl = 0; tl < 2; ++tl) { const int id = F.wave * 2 + tl, st = id >> 2, tt = id & 3;
                    f32x4 a = (f32x4){0.f, 0.f, 0.f, 0.f};
                    if (tt >= st) {
#pragma unroll
                        for (int ks = 0; ks < 4; ++ks) { const hb8 fa = *(const LAS hb8*)(Kt + (st * 16 + l15) * HQS + ks * 32 + q4 * 8), fb = *(const LAS hb8*)(Qt + (tt * 16 + l15) * HQS + ks * 32 + q4 * 8);
                            a = MFMA16(fa, fb, a); }
                    }
                    const int tg = tt * 16 + l15, sg = st * 16 + q4 * 4;
                    const float a0 = (sg + 0 <= tg) ? a.x : 0.f, a1 = (sg + 1 <= tg) ? a.y : 0.f, a2 = (sg + 2 <= tg) ? a.z : 0.f, a3 = (sg + 3 <= tg) ? a.w : 0.f;
                    *(LAS v2u*)(ATT + tg * HTS + sg) = (v2u){pk2(a0, a1), pk2(a2, a3)}; }
                f32x4 Oa[4];
#pragma unroll
                for (int tt = 0; tt < 4; ++tt) Oa[tt] = (f32x4){0.f, 0.f, 0.f, 0.f};
#pragma unroll
                for (int ks = 0; ks < 4; ++ks) {
                    const v4u sb4 = (v4u){pk2(S[2 * ks].x, S[2 * ks].y), pk2(S[2 * ks].z, S[2 * ks].w), pk2(S[2 * ks + 1].x, S[2 * ks + 1].y), pk2(S[2 * ks + 1].z, S[2 * ks + 1].w)};
                    const hb8 fb = __builtin_bit_cast(hb8, sb4);
#pragma unroll
                    for (int tt = 0; tt < 4; ++tt) { const v2u a0 = *(const LAS v2u*)(Qt + (tt * 16 + l15) * HQS + ks * 32 + q4 * 4), a1 = *(const LAS v2u*)(Qt + (tt * 16 + l15) * HQS + ks * 32 + 16 + q4 * 4);
                        const v4u fa4 = (v4u){a0.x, a0.y, a1.x, a1.y}; Oa[tt] = MFMA16(__builtin_bit_cast(hb8, fa4), fb, Oa[tt]); } }
                LDS_BARRIER();
#pragma unroll
                for (int ss = 0; ss < 2; ++ss) { const hb8 fb = *(const LAS hb8*)(VT + (vb * 16 + l15) * HTS + ss * 32 + q4 * 8);
#pragma unroll
                    for (int tt = 0; tt < 4; ++tt) { const hb8 fa = *(const LAS hb8*)(ATT + (tt * 16 + l15) * HTS + ss * 32 + q4 * 8); Oa[tt] = MFMA16(fa, fb, Oa[tt]); }
#pragma unroll
                    for (int kt = 0; kt < 8; ++kt) { const hb8 fa = *(const LAS hb8*)(KtT + (kt * 16 + l15) * HTS + ss * 32 + q4 * 8); S[kt] = MFMA16(fa, fb, S[kt]); } }
#pragma unroll
                for (int kt = 0; kt < 8; ++kt) { const f32x4 e4 = *(const LAS f32x4*)(eend + kt * 16 + q4 * 4); S[kt] = S[kt] * e4; }
#pragma unroll
                for (int tt = 0; tt < 4; ++tt) {
#pragma unroll
                    for (int i = 0; i < 4; ++i) O32[(tt * 16 + q4 * 4 + i) * HOS + vb * 16 + l15] = Oa[tt][i]; }
                LDS_BARRIER();
                {
                    f32x4 o[4];
#pragma unroll
                    for (int u = 0; u < 4; ++u) o[u] = *(const LAS f32x4*)(O32 + rto * HOS + g8o * 16 + u * 4);
                    if (d == 0) {
                        GAS v4u* ofp = (GAS v4u*)((GAS char*)(OF + h * 128) + ((unsigned)rrow * DM + g8o * 16) * 2u);
                        ofp[0] = (v4u){pk2(o[0].x, o[0].y), pk2(o[0].z, o[0].w), pk2(o[1].x, o[1].y), pk2(o[1].z, o[1].w)};
                        ofp[1] = (v4u){pk2(o[2].x, o[2].y), pk2(o[2].z, o[2].w), pk2(o[3].x, o[3].y), pk2(o[3].z, o[3].w)};
                    } else if (do_out) {
                        float ss = 0.f;
#pragma unroll
                        for (int u2 = 0; u2 < 2; ++u2) { const v4u f = pf[u2];
                            o[2 * u2] = o[2 * u2] + (f32x4){bflo(f.x), bfhi(f.x), bflo(f.y), bfhi(f.y)}; o[2 * u2 + 1] = o[2 * u2 + 1] + (f32x4){bflo(f.z), bfhi(f.z), bflo(f.w), bfhi(f.w)}; }
#pragma unroll
                        for (int u = 0; u < 4; ++u) ss += (o[u].x * o[u].x + o[u].y * o[u].y) + (o[u].z * o[u].z + o[u].w * o[u].w);
                        ss = sum8(ss);
                        const float r = __builtin_amdgcn_rsqf(ss * (1.f / 128.f) + RMS_EPS);
                        GAS v4u* gp = (GAS v4u*)((GAS char*)(P + 4 * DM + h * 128) + ((unsigned)rrow * HG_N + g8o * 16) * 2u);
#pragma unroll
                        for (int u2 = 0; u2 < 2; ++u2) { const v4u rg = pg[u2]; const f32x4 oa = o[2 * u2], ob2 = o[2 * u2 + 1]; const f32x4 nga = *(const LAS f32x4*)(s_ng + g8o * 16 + u2 * 8), ngb = *(const LAS f32x4*)(s_ng + g8o * 16 + u2 * 8 + 4); const float ngp[8] = {nga.x, nga.y, nga.z, nga.w, ngb.x, ngb.y, ngb.z, ngb.w};
                            const float y0 = oa.x * r * ngp[0] * bflo(rg.x), y1 = oa.y * r * ngp[1] * bfhi(rg.x), y2 = oa.z * r * ngp[2] * bflo(rg.y), y3 = oa.w * r * ngp[3] * bfhi(rg.y);
                            const float y4 = ob2.x * r * ngp[4] * bflo(rg.z), y5 = ob2.y * r * ngp[5] * bfhi(rg.z), y6 = ob2.z * r * ngp[6] * bflo(rg.w), y7 = ob2.w * r * ngp[7] * bfhi(rg.w);
                            gp[u2] = (v4u){pk2(y0, y1), pk2(y2, y3), pk2(y4, y5), pk2(y6, y7)}; }
                    }
                }
            }
            __threadfence(); __syncthreads();
        }
    }
}

constexpr int GS = 136, GT = 80, GB = 40;
constexpr int GD_KC = 0, GD_QC = 17408, GD_KCT = 34816, GD_VT = 55296, GD_SB = 75776, GD_O16 = 110592, GD_RAW = 75776, GD_TUB = 128000, GD_TWB = 133120, GD_QKB = 138240, GD_LB = 143360, GD_SC = 148480;
constexpr int GW_RAW = 0, GW_ROW = 69632, GW_TR = 102400, GWT = 72;
__device__ __forceinline__ void gdn_conv_sweep(Frame& F, int b, int hq) {
    gb P = (gb)(F.ws + WS_P); gb KT = (gb)(F.ws + WS_H); gcf cwt = F.in[I_GDNCW];
    LAS bf16* RAW = (LAS bf16*)(F.lds + GW_RAW); LAS bf16* ROW = (LAS bf16*)(F.lds + GW_ROW); LAS bf16* TR = (LAS bf16*)(F.lds + GW_TR);
    const int tid_ = F.tid;
    __syncthreads();
    v2f cwp[5];
    { const int p = tid_ & 255, c = 2 * p; const int ccol = (c < 128) ? (hq * 128 + c) : (c < 256) ? (DM + hq * 128 + (c - 128)) : (2 * DM + hq * 256 + (c - 256));
#pragma unroll
      for (int t = 0; t < 5; ++t) cwp[t] = *(GAS const v2f*)(cwt + t * (4 * DM) + ccol); }
    v4u rawp[9];
#define GW_PREFETCH(st_) do { const int s0_ = (st_) * 64; const bool isctx_ = s0_ < TCX; const int slen_ = isctx_ ? TCX : TL, plo_ = isctx_ ? s0_ : s0_ - TCX, rowbase_ = isctx_ ? b * TCX : ROWS_C + b * TL; \
        _Pragma("unroll") for (int n_ = 0; n_ < 9; ++n_) { const int idx_ = tid + NTHREADS * n_; const int rr_ = idx_ >> 6, pc_ = idx_ & 63; const int pp_ = plo_ - 2 + rr_; \
            const int col_ = (pc_ < 16) ? (hq * 128 + pc_ * 8) : (pc_ < 32) ? (DM + hq * 128 + (pc_ - 16) * 8) : (2 * DM + hq * 256 + (pc_ - 32) * 8); \
            rawp[n_] = (idx_ < 68 * 64 && pp_ >= 0 && pp_ < slen_) ? *(GAS const v4u*)(P + (size_t)(rowbase_ + pp_) * GDN_NP + col_) : (v4u){0u, 0u, 0u, 0u}; } } while (0)
    { int tid = tid_; asm volatile("" : "+v"(tid)); GW_PREFETCH(0); }
#pragma unroll 1
    for (int st = 0; st < (TCX + TL) / 64; ++st) {
        const int s0 = st * 64; const bool isctx = s0 < TCX; const int plo = isctx ? s0 : s0 - TCX, rowbase = isctx ? b * TCX : ROWS_C + b * TL;
        int tid = tid_; asm volatile("" : "+v"(tid));
        LDS_BARRIER();
#pragma unroll
        for (int n = 0; n < 9; ++n) { const int idx = tid + NTHREADS * n; if (idx < 68 * 64) *(LAS v4u*)(RAW + (idx >> 6) * 512 + (idx & 63) * 8) = rawp[n]; }
        if (st + 1 < (TCX + TL) / 64) GW_PREFETCH(st + 1);
        LDS_BARRIER();
        const int p = tid & 255, cls = __builtin_amdgcn_readfirstlane(p >> 6);
#pragma unroll 1
        for (int n = 0; n < 4; ++n) {
            const int g = (tid >> 8) + 2 * n;
            v2f w[12];
#pragma unroll
            for (int e = 0; e < 12; ++e) { const unsigned x = *(const LAS unsigned*)(RAW + (g * 8 + e) * 512 + 2 * p); w[e] = (v2f){bflo(x), bfhi(x)}; }
            v2f sv[8];
#pragma unroll
            for (int e = 0; e < 8; ++e) {
                v2f a = w[e] * cwp[0]; a = w[e + 1] * cwp[1] + a; a = w[e + 2] * cwp[2] + a; a = w[e + 3] * cwp[3] + a; a = w[e + 4] * cwp[4] + a;
                const v2f na = a * (-1.4426950408889634f);
                v2f ex; ex.x = __builtin_amdgcn_exp2f(na.x); ex.y = __builtin_amdgcn_exp2f(na.y);
                const v2f den = ex + 1.0f;
                v2f rc; rc.x = __builtin_amdgcn_rcpf(den.x); rc.y = __builtin_amdgcn_rcpf(den.y);
                sv[e] = a * rc;
            }
            if (cls < 2) {
#pragma unroll
                for (int e = 0; e < 8; ++e) *(LAS unsigned*)(ROW + (g * 8 + e) * 256 + 2 * p) = pk2(sv[e].x, sv[e].y);
            }
            if (cls >= 1) {
                LAS bf16* tr = TR + 2 * (p - 64) * GWT + g * 8;
                *(LAS v4u*)(tr) = (v4u){pk2(sv[0].x, sv[1].x), pk2(sv[2].x, sv[3].x), pk2(sv[4].x, sv[5].x), pk2(sv[6].x, sv[7].x)};
                *(LAS v4u*)(tr + GWT) = (v4u){pk2(sv[0].y, sv[1].y), pk2(sv[2].y, sv[3].y), pk2(sv[4].y, sv[5].y), pk2(sv[6].y, sv[7].y)};
            }
        }
        asm volatile("s_waitcnt vmcnt(0)" ::: "memory");
        LDS_BARRIER();
        const size_t grow = (size_t)(rowbase + plo);
#pragma unroll
        for (int n = 0; n < 4; ++n) { const int idx = tid + NTHREADS * n; const int rr = idx >> 5, pc = idx & 31;
            const int col = (pc < 16) ? (hq * 128 + pc * 8) : (DM + hq * 128 + (pc - 16) * 8);
            *(GAS v4u*)(P + (grow + rr) * GDN_NP + col) = *(const LAS v4u*)(ROW + rr * 256 + pc * 8); }
#pragma unroll
        for (int n = 0; n < 2; ++n) { const int idx = tid + NTHREADS * n; const int ch = idx >> 3, pc = idx & 7;
            *(GAS v4u*)(KT + ((grow >> 6) * 16 + hq) * 8192 + ch * 64 + pc * 8) = *(const LAS v4u*)(TR + ch * GWT + pc * 8); }
#pragma unroll
        for (int n = 0; n < 4; ++n) { const int idx = tid + NTHREADS * n; const int c = idx >> 3, pc = idx & 7, ch = c & 127;
            *(GAS v4u*)(P + (grow + (ch >> 1)) * GDN_NP + 2 * DM + hq * 256 + (c >> 7) * 128 + (ch & 1) * 64 + pc * 8) = *(const LAS v4u*)(TR + (128 + c) * GWT + pc * 8); }
    }
#undef GW_PREFETCH
    __threadfence(); __syncthreads();
}
template <int CTRL> __device__ __forceinline__ float dpp0(float x) { return __builtin_bit_cast(float, __builtin_amdgcn_update_dpp(0, __builtin_bit_cast(int, x), CTRL, 0xf, 0xf, true)); }
__device__ __forceinline__ void phase_gdn2(Frame& F, bool ctx_out, bool dry = false) {
    FRAME_TID(F);
    gb P = (gb)(F.ws + WS_P); gb OB = (gb)(F.ws + WS_O); gb KT = (gb)(F.ws + WS_H);
    gcf alog = F.in[I_GDNALOG]; gcf dtb = F.in[I_GDNDTB]; gcf ng = F.in[I_GDNNG];
    LAS bf16* KC = (LAS bf16*)(F.lds + GD_KC); LAS bf16* QC = (LAS bf16*)(F.lds + GD_QC); LAS bf16* KCT = (LAS bf16*)(F.lds + GD_KCT); LAS bf16* VT = (LAS bf16*)(F.lds + GD_VT);
    LAS bf16* O16 = (LAS bf16*)(F.lds + GD_O16);
    LAS bf16* TUB = (LAS bf16*)(F.lds + GD_TUB); LAS bf16* TWB = (LAS bf16*)(F.lds + GD_TWB); LAS bf16* QKB = (LAS bf16*)(F.lds + GD_QKB);
    LAS float* LB = (LAS float*)(F.lds + GD_LB); LAS float* s_ng = (LAS float*)(F.lds + 151552);
    LAS float* s_gate0 = (LAS float*)(F.lds + GD_SC);
    LAS float* s_ckd = s_gate0 + 416; LAS float* s_rq = s_ckd + 64; LAS float* s_rk = s_rq + 64;
    LAS bf16* W = KC;
    const int vb = F.wave;
    const int tid_ = F.tid, lane_ = F.lane;
    for (int item2 = blockIdx.x; item2 < NB * 16; item2 += F.G) {
      gdn_conv_sweep(F, item2 >> 4, item2 & 15);
      for (int ev = 0; ev < 2; ++ev) {
        const int item = item2 * 2 + ev;
        const int b = item >> 5, hv = item & 31, hq = hv >> 1;
        LDS_BARRIER();
        for (int i = tid_; i < 3 * 5120 / 16; i += NTHREADS) ((LAS v4u*)(F.lds + GD_TUB))[i] = (v4u){0u, 0u, 0u, 0u};
        if (tid_ < 128) s_ng[tid_] = ng[tid_];
        for (int i = tid_; i < 256 * 2; i += NTHREADS) { const int r = i >> 1, hh = i & 1; LAS bf16* img = (r < 128) ? KCT : VT; *(LAS v4u*)(img + (r & 127) * GT + 64 + hh * 8) = (v4u){0u, 0u, 0u, 0u}; }
        for (int d = 0; d < 2; ++d) {
            const float dtbv = dtb[d * 32 + hv], aexp = __expf(alog[d * 32 + hv]);
            f32x4 S[8];
#pragma unroll
            for (int kt = 0; kt < 8; ++kt) S[kt] = (f32x4){0.f, 0.f, 0.f, 0.f};
            v4u rawp[8]; unsigned short gpb_ = 0, gpa_ = 0;
#define GDN_PREFETCH(st_) do { const int s0_ = (st_) * 64; const bool isctx_ = s0_ < TCX; const int slen_ = isctx_ ? TCX : TL, sp0_ = isctx_ ? s0_ : s0_ - TCX; \
                const int plo_ = d ? (slen_ - 64 - sp0_) : sp0_, rowbase_ = isctx_ ? b * TCX : ROWS_C + b * TL; \
                {   \
                  GAS const char* ubq_ = (GAS const char*)(P + (size_t)(rowbase_ + plo_) * GDN_NP + hq * 128); \
                  const unsigned lo_ = ((unsigned)(tid >> 4) * GDN_NP + (tid & 15) * 8) * 2u, lo32_ = lo_ + 32u * GDN_NP * 2u; \
                  rawp[0] = *(GAS const v4u*)(ubq_ + lo_); rawp[1] = *(GAS const v4u*)(ubq_ + lo32_); rawp[2] = *(GAS const v4u*)(ubq_ + DM * 2 + lo_); rawp[3] = *(GAS const v4u*)(ubq_ + DM * 2 + lo32_); \
                  GAS const char* ubk_ = (GAS const char*)(KT + ((size_t)((rowbase_ + plo_) >> 6) * 16 + hq) * 8192); const unsigned lk_ = (unsigned)tid * 16u; \
                  rawp[4] = *(GAS const v4u*)(ubk_ + lk_); rawp[5] = *(GAS const v4u*)(ubk_ + 8192 + lk_); \
                  GAS const char* ubv_ = (GAS const char*)(P + (size_t)(rowbase_ + plo_) * GDN_NP + 2 * DM + hv * 128); \
                  rawp[6] = *(GAS const v4u*)(ubv_ + lo_); rawp[7] = *(GAS const v4u*)(ubv_ + lo32_); } \
                if (tid >= 448) { const int ti_ = tid - 448; const int pp_ = d ? (plo_ + 63 - ti_) : (plo_ + ti_); gcb pr_ = P + (size_t)(rowbase_ + pp_) * GDN_NP + 3 * 2 * DM + d * 64 + hv; \
                    gpb_ = pr_[0]; gpa_ = pr_[32]; } } while (0)
#define GDN_GATES(par_) do { LAS float* gb_ = s_gate0 + (par_) * 208; const int ti = tid - 448; \
                const float xb = bf2f(gpb_), xa = bf2f(gpa_) + dtbv; \
                const float sp = (xa > 20.f) ? xa : log1pf(__expf(xa)); \
                const float be = sigmoid_f(xb); float gg = -aexp * sp; \
                gg += dpp0<0x111>(gg); gg += dpp0<0x112>(gg); gg += dpp0<0x114>(gg); gg += dpp0<0x118>(gg);     \
                gb_[ti] = be; gb_[64 + ti] = gg; gb_[128 + ti] = __expf(gg); \
                if ((ti & 15) == 15) gb_[192 + (ti >> 4)] = __expf(gg); } while (0)
#define GDN_RD_LOAD(row_, f0_, f1_, z0_, z1_) do { GAS const char* ob_ = (GAS const char*)(OB + hv * 128); const unsigned oo_ = ((unsigned)(row_) * (2 * DM) + g8 * 16) * 2u; f0_ = *(GAS const v4u*)(ob_ + oo_); f1_ = *(GAS const v4u*)(ob_ + oo_ + 16); \
                GAS const char* zb_ = (GAS const char*)(P + 4 * DM + hv * 128); const unsigned zo_ = ((unsigned)(row_) * GDN_NP + g8 * 16) * 2u; z0_ = *(GAS const v4u*)(zb_ + zo_); z1_ = *(GAS const v4u*)(zb_ + zo_ + 16); } while (0)
#define GDN_RD_OUT(tk_, f0_, f1_, z0_, z1_) do { const int rt_ = (tk_), g8_ = lane & 7; const int rrow_ = rowbase + (d ? (plo + 63 - rt_) : (plo + rt_)); \
                const v4u o0 = *(const LAS v4u*)(O16 + rt_ * GS + g8_ * 16), o1 = *(const LAS v4u*)(O16 + rt_ * GS + g8_ * 16 + 8); \
                if (d == 0) { GAS v4u* op = (GAS v4u*)((GAS char*)(OB + hv * 128) + ((unsigned)rrow_ * (2 * DM) + g8_ * 16) * 2u); op[0] = o0; op[1] = o1; } \
                else if (do_out) { \
                    GAS v4u* zp = (GAS v4u*)((GAS char*)(P + 4 * DM + hv * 128) + ((unsigned)rrow_ * GDN_NP + g8_ * 16) * 2u); \
                    const v4u f0 = f0_, f1 = f1_; \
                    float o[16]; \
                    o[0] = bflo(o0.x) + bflo(f0.x); o[1] = bfhi(o0.x) + bfhi(f0.x); o[2] = bflo(o0.y) + bflo(f0.y); o[3] = bfhi(o0.y) + bfhi(f0.y); \
                    o[4] = bflo(o0.z) + bflo(f0.z); o[5] = bfhi(o0.z) + bfhi(f0.z); o[6] = bflo(o0.w) + bflo(f0.w); o[7] = bfhi(o0.w) + bfhi(f0.w); \
                    o[8] = bflo(o1.x) + bflo(f1.x); o[9] = bfhi(o1.x) + bfhi(f1.x); o[10] = bflo(o1.y) + bflo(f1.y); o[11] = bfhi(o1.y) + bfhi(f1.y); \
                    o[12] = bflo(o1.z) + bflo(f1.z); o[13] = bfhi(o1.z) + bfhi(f1.z); o[14] = bflo(o1.w) + bflo(f1.w); o[15] = bfhi(o1.w) + bfhi(f1.w); \
                    float ss = 0.f; \
                    _Pragma("unroll") for (int t = 0; t < 16; ++t) ss += o[t] * o[t]; \
                    ss = sum8(ss); \
                    const float r = __builtin_amdgcn_rsqf(ss * (1.f / 128.f) + RMS_EPS); \
                    _Pragma("unroll") for (int u2 = 0; u2 < 2; ++u2) { const v4u z = u2 ? z1_ : z0_; const f32x4 nga = *(const LAS f32x4*)(s_ng + g8_ * 16 + u2 * 8), ngb = *(const LAS f32x4*)(s_ng + g8_ * 16 + u2 * 8 + 4); const float ngp[8] = {nga.x, nga.y, nga.z, nga.w, ngb.x, ngb.y, ngb.z, ngb.w}; const float* oo = o + u2 * 8; \
                        const float y0 = oo[0] * r * ngp[0] * bflo(z.x), y1 = oo[1] * r * ngp[1] * bfhi(z.x), y2 = oo[2] * r * ngp[2] * bflo(z.y), y3 = oo[3] * r * ngp[3] * bfhi(z.y); \
                        const float y4 = oo[4] * r * ngp[4] * bflo(z.z), y5 = oo[5] * r * ngp[5] * bfhi(z.z), y6 = oo[6] * r * ngp[6] * bflo(z.w), y7 = oo[7] * r * ngp[7] * bfhi(z.w); \
                        zp[u2] = (v4u){pk2(y0, y1), pk2(y2, y3), pk2(y4, y5), pk2(y6, y7)}; } \
                } } while (0)
            { int tid = tid_; asm volatile("" : "+v"(tid)); GDN_PREFETCH(0); if (tid >= 448) GDN_GATES(0); }
#pragma unroll 1
            for (int st = 0; st < (TCX + TL) / 64; ++st) {
                const int s0 = st * 64; const bool isctx = s0 < TCX; const int slen = isctx ? TCX : TL, sp0 = isctx ? s0 : s0 - TCX;
                const int plo = d ? (slen - 64 - sp0) : sp0, rowbase = isctx ? b * TCX : ROWS_C + b * TL;
                int tid = tid_, lane = lane_; asm volatile("" : "+v"(tid), "+v"(lane));
                const int stp = st > 0 ? st - 1 : 0; const int s0p = stp * 64; const bool isctxp = s0p < TCX; const int slenp = isctxp ? TCX : TL, sp0p = isctxp ? s0p : s0p - TCX;
                const int plop = d ? (slenp - 64 - sp0p) : sp0p, rowbasep = isctxp ? b * TCX : ROWS_C + b * TL;
                const bool do_outp = (d == 1) && !dry && st > 0 && (ctx_out || !isctxp);
                const int tkA = (vb == 0) ? 0 : 8 * (vb - 1) + (lane >> 3);
                v4u pfA0, pfA1, pzA0, pzA1;
                { const int g8 = lane & 7; const int rowA = do_outp ? rowbasep + (plop + 63 - tkA) : 0; GDN_RD_LOAD(rowA, pfA0, pfA1, pzA0, pzA1); }
                const int l15 = lane & 15, q4 = lane >> 4;
                LAS float* s_beta = s_gate0 + (st & 1) * 208; LAS float* s_G = s_beta + 64; LAS float* s_eG = s_beta + 128; LAS float* s_eGend = s_beta + 192;
                {
                    const int r0 = tid >> 4, pc = (tid & 15) * 8;
                    const int t0 = d ? 63 - r0 : r0, t1 = d ? 31 - r0 : r0 + 32;
                    *(LAS v4u*)(QC + t0 * GS + pc) = rawp[0]; *(LAS v4u*)(QC + t1 * GS + pc) = rawp[1];
                    *(LAS v4u*)(KC + t0 * GS + pc) = rawp[2]; *(LAS v4u*)(KC + t1 * GS + pc) = rawp[3];
                    const int pcs = tid & 7, tp = d ? 56 - pcs * 8 : pcs * 8;
                    v4u x4 = rawp[4], x5 = rawp[5], x6 = rawp[6], x7 = rawp[7];
                    if (d) {
#define GDN_REV(x_) x_ = (v4u){__builtin_amdgcn_alignbit(x_.w, x_.w, 16), __builtin_amdgcn_alignbit(x_.z, x_.z, 16), __builtin_amdgcn_alignbit(x_.y, x_.y, 16), __builtin_amdgcn_alignbit(x_.x, x_.x, 16)}
                        GDN_REV(x4); GDN_REV(x5); GDN_REV(x6); GDN_REV(x7);
#undef GDN_REV
                    }
                    const int kch = tid >> 3;
                    *(LAS v4u*)(KCT + kch * GT + tp) = x4; *(LAS v4u*)(KCT + (kch + 64) * GT + tp) = x5;
                    const int vch = 2 * r0 + ((tid >> 3) & 1);
                    *(LAS v4u*)(VT + vch * GT + tp) = x6; *(LAS v4u*)(VT + (vch + 64) * GT + tp) = x7;
                }
                if (st + 1 < (TCX + TL) / 64) GDN_PREFETCH(st + 1);
                LDS_BARRIER();
                {
                    const int t = tid >> 3, which = (tid >> 2) & 1, part = tid & 3;
                    const LAS v4u* src = (const LAS v4u*)((which ? KC : QC) + t * GS + part * 32);
                    float ss = 0.f;
#pragma unroll
                    for (int u = 0; u < 4; ++u) { const v4u x = src[u]; const float f0 = bflo(x.x), f1 = bfhi(x.x), f2 = bflo(x.y), f3 = bfhi(x.y), f4 = bflo(x.z), f5 = bfhi(x.z), f6 = bflo(x.w), f7 = bfhi(x.w);
                        ss += (f0 * f0 + f1 * f1) + (f2 * f2 + f3 * f3) + (f4 * f4 + f5 * f5) + (f6 * f6 + f7 * f7); }
                    ss += dppf<0xB1>(ss); ss += dppf<0x4E>(ss);
                    if (part == 0) { const float r = __builtin_amdgcn_rsqf(ss + RMS_EPS); if (which) s_rk[t] = r; else s_rq[t] = r * 0.08838834764831845f; }
                }
                f32x4 blk = (f32x4){0.f, 0.f, 0.f, 0.f};
                const int bI = vb & 3;
                {
                    LAS bf16* bimg = (vb < 4) ? KC : QC;
#pragma unroll
                    for (int ks = 0; ks < 4; ++ks) { const hb8 fa = *(const LAS hb8*)(KC + (bI * 16 + l15) * GS + ks * 32 + q4 * 8), fb = *(const LAS hb8*)(bimg + (bI * 16 + l15) * GS + ks * 32 + q4 * 8);
                        blk = MFMA16(fa, fb, blk); }
                }
                LDS_BARRIER();
                {
                    const int t = bI * 16 + l15, sb0 = bI * 16 + q4 * 4;
                    const float Gt = s_G[t]; const f32x4 Gs = *(const LAS f32x4*)(s_G + sb0), rks = *(const LAS f32x4*)(s_rk + sb0);
                    if (vb < 4) {
                        const float rowf = s_beta[t] * s_rk[t];
                        f32x4 lv;
#pragma unroll
                        for (int i = 0; i < 4; ++i) lv[i] = (q4 * 4 + i < l15) ? rowf * rks[i] * blk[i] * __expf(Gt - Gs[i]) : 0.f;
                        *(LAS f32x4*)(LB + (bI * 16 + l15) * 20 + q4 * 4) = lv;
                    } else {
                        float qv[4];
#pragma unroll
                        for (int i = 0; i < 4; ++i) qv[i] = (q4 * 4 + i <= l15) ? rks[i] * blk[i] * __expf(Gt - Gs[i]) : 0.f;
                        *(LAS v2u*)(QKB + (bI * 16 + l15) * GB + q4 * 4) = (v2u){pk2(qv[0], qv[1]), pk2(qv[2], qv[3])};
                    }
                    if (tid >= 448) { const int ti = tid - 448; s_ckd[ti] = s_rk[ti] * __expf(s_G[(ti & 48) + 15] - s_G[ti]); }
                }
                LDS_BARRIER();
                if (vb == 7) {
                    const int plo = plop, rowbase = rowbasep; const bool do_out = do_outp;
                    v4u pfB0, pfB1, pzB0, pzB1;
                    { const int g8 = lane & 7; const int rowB = do_outp ? rowbasep + (plop + 63 - (tkA + 8)) : 0; GDN_RD_LOAD(rowB, pfB0, pfB1, pzB0, pzB1); }
                    if (st + 1 < (TCX + TL) / 64) GDN_GATES((st + 1) & 1);
                    if (st > 0) { GDN_RD_OUT(tkA, pfA0, pfA1, pzA0, pzA1); GDN_RD_OUT(tkA + 8, pfB0, pfB1, pzB0, pzB1); }
                } else if (vb != 0) {
                    const int plo = plop, rowbase = rowbasep; const bool do_out = do_outp;
                    if (st > 0) GDN_RD_OUT(tkA, pfA0, pfA1, pzA0, pzA1);
                }
                if (vb == 0) {
                    __builtin_amdgcn_s_setprio(3);
                    const int I = lane >> 4, jc = lane & 15;
                    const LAS float* Lr = LB + (I * 16) * 20;
                    f32x4 la[8][2], lb[7][4];
#pragma unroll
                    for (int t = 1; t <= 8; ++t) { la[t - 1][0] = *(const LAS f32x4*)(Lr + t * 20); if (t > 4) la[t - 1][1] = *(const LAS f32x4*)(Lr + t * 20 + 4); }
                    asm volatile("" ::: "memory");
#pragma unroll
                    for (int t = 9; t <= 15; ++t) { lb[t - 9][0] = *(const LAS f32x4*)(Lr + t * 20); lb[t - 9][1] = *(const LAS f32x4*)(Lr + t * 20 + 4); lb[t - 9][2] = *(const LAS f32x4*)(Lr + t * 20 + 8); if (t > 12) lb[t - 9][3] = *(const LAS f32x4*)(Lr + t * 20 + 12); }
                    f32x4 T4[4];
#pragma unroll
                    for (int k = 0; k < 4; ++k) T4[k] = (f32x4){0.f, 0.f, 0.f, 0.f};
                    T4[0][0] = (jc == 0) ? 1.f : 0.f;
#pragma unroll
                    for (int t = 1; t <= 15; ++t) {
                        f32x4 acc = (t <= 8) ? la[t - 1][0] * T4[0] : lb[t - 9][0] * T4[0];
                        if (t > 4) acc = acc + ((t <= 8) ? la[t - 1][1] * T4[1] : lb[t - 9][1] * T4[1]);
                        if (t > 8) acc = acc + lb[t > 8 ? t - 9 : 0][2] * T4[2];
                        if (t > 12) acc = acc + lb[t > 8 ? t - 9 : 0][3] * T4[3];
                        const float a = ((t == jc) ? 1.f : 0.f) - ((acc.x + acc.y) + (acc.z + acc.w));
                        T4[t >> 2][t & 3] = a;
                    }
                    const int sj = I * 16 + jc; const float cu = s_beta[sj], cwv = cu * s_rk[sj] * s_eG[sj];
#pragma unroll
                    for (int t = 0; t < 16; ++t) { const float tv = T4[t >> 2][t & 3]; TUB[(I * 16 + t) * GB + jc] = (bf16)f2bf(tv * cu); TWB[(I * 16 + t) * GB + jc] = (bf16)f2bf(tv * cwv); }
                    __builtin_amdgcn_s_setprio(0);
                }
                LDS_BARRIER();
                f32x4 U[4];
#pragma unroll
                for (int I = 0; I < 4; ++I) {
                    const hb8 fa = *(const LAS hb8*)(TUB + (I * 16 + l15) * GB + q4 * 8), fb = *(const LAS hb8*)(VT + (vb * 16 + l15) * GT + I * 16 + q4 * 8);
                    U[I] = MFMA16(fa, fb, ((f32x4){0.f, 0.f, 0.f, 0.f}));
                    const hb8 ga = *(const LAS hb8*)(KCT + (vb * 16 + l15) * GT + I * 16 + q4 * 8), gbv = *(const LAS hb8*)(TWB + (I * 16 + l15) * GB + q4 * 8);
                    const f32x4 wt = MFMA16(ga, gbv, ((f32x4){0.f, 0.f, 0.f, 0.f}));
                    *(LAS v2u*)(W + (I * 16 + l15) * GS + vb * 16 + q4 * 4) = (v2u){pk2(-wt.x, -wt.y), pk2(-wt.z, -wt.w)};
                }
                LDS_WAIT(); asm volatile("" ::: "memory");
                LDS_BARRIER();
#pragma unroll
                for (int I = 0; I < 4; ++I) {
                    f32x4 vn = U[I], oa = (f32x4){0.f, 0.f, 0.f, 0.f};
#pragma unroll
                    for (int ks = 0; ks < 4; ++ks) {
                        const v4u sb4 = (v4u){pk2(S[2 * ks].x, S[2 * ks].y), pk2(S[2 * ks].z, S[2 * ks].w), pk2(S[2 * ks + 1].x, S[2 * ks + 1].y), pk2(S[2 * ks + 1].z, S[2 * ks + 1].w)};
                        const hb8 fb = __builtin_bit_cast(hb8, sb4);
                        const v2u w0 = *(const LAS v2u*)(W + (I * 16 + l15) * GS + ks * 32 + q4 * 4), w1 = *(const LAS v2u*)(W + (I * 16 + l15) * GS + ks * 32 + 16 + q4 * 4);
                        const v2u q0 = *(const LAS v2u*)(QC + (I * 16 + l15) * GS + ks * 32 + q4 * 4), q1 = *(const LAS v2u*)(QC + (I * 16 + l15) * GS + ks * 32 + 16 + q4 * 4);
                        const v4u fw4 = (v4u){w0.x, w0.y, w1.x, w1.y}, fq4 = (v4u){q0.x, q0.y, q1.x, q1.y};
                        vn = MFMA16(__builtin_bit_cast(hb8, fw4), fb, vn); oa = MFMA16(__builtin_bit_cast(hb8, fq4), fb, oa); }
                    const f32x4 ck = *(const LAS f32x4*)(s_ckd + I * 16 + q4 * 4), eg = *(const LAS f32x4*)(s_eG + I * 16 + q4 * 4), rqv = *(const LAS f32x4*)(s_rq + I * 16 + q4 * 4);
                    const v4u vn4 = (v4u){pk2(vn.x, vn.y), pk2(vn.z, vn.w), 0u, 0u}, vp4 = (v4u){pk2(vn.x * ck.x, vn.y * ck.y), pk2(vn.z * ck.z, vn.w * ck.w), 0u, 0u};
                    oa = oa * eg;
                    { const v2u a0 = *(const LAS v2u*)(QKB + (I * 16 + l15) * GB + q4 * 4); const v4u fa4 = (v4u){a0.x, a0.y, 0u, 0u}; oa = MFMA16(__builtin_bit_cast(hb8, fa4), __builtin_bit_cast(hb8, vn4), oa); }
                    oa = oa * rqv;
#pragma unroll
                    for (int i = 0; i < 4; ++i) O16[(I * 16 + q4 * 4 + i) * GS + vb * 16 + l15] = (bf16)f2bf(oa[i]);
                    const float ege = s_eGend[I];
                    const hb8 fbn = __builtin_bit_cast(hb8, vp4);
#pragma unroll
                    for (int kt = 0; kt < 8; ++kt) { const v2u a0 = *(const LAS v2u*)(KCT + (kt * 16 + l15) * GT + I * 16 + q4 * 4); const v4u fa4 = (v4u){a0.x, a0.y, 0u, 0u}; S[kt] = MFMA16(__builtin_bit_cast(hb8, fa4), fbn, S[kt] * ege); }
                }
                LDS_BARRIER();
            }
            if (vb != 0) {
                const int st = (TCX + TL) / 64 - 1; const int s0 = st * 64; const int sp0 = s0 - TCX;
                const int plo = d ? (TL - 64 - sp0) : sp0, rowbase = ROWS_C + b * TL;
                int lane = lane_; asm volatile("" : "+v"(lane));
                const bool do_out = (d == 1) && !dry;
                const int tkA = 8 * (vb - 1) + (lane >> 3), g8 = lane & 7;
                v4u pfA0, pfA1, pzA0, pzA1;
                GDN_RD_LOAD(do_out ? rowbase + (plo + 63 - tkA) : 0, pfA0, pfA1, pzA0, pzA1);
                GDN_RD_OUT(tkA, pfA0, pfA1, pzA0, pzA1);
                if (vb == 7) { v4u pfB0, pfB1, pzB0, pzB1; GDN_RD_LOAD(do_out ? rowbase + (plo + 63 - (tkA + 8)) : 0, pfB0, pfB1, pzB0, pzB1); GDN_RD_OUT(tkA + 8, pfB0, pfB1, pzB0, pzB1); }
            }
#undef GDN_PREFETCH
#undef GDN_GATES
#undef GDN_RD_LOAD
#undef GDN_RD_OUT
            __threadfence(); __syncthreads();
        }
      }
    }
}

constexpr int NKS = 40, NVS = 1032;
constexpr int NA_KI = 0, NA_VTI = 81920, NA_BIAS = 147968;
__device__ __forceinline__ float xq_max(float x) {
    auto s = __builtin_amdgcn_permlane16_swap(__float_as_uint(x), __float_as_uint(x), false, false); x = fmaxf(__uint_as_float(s[0]), __uint_as_float(s[1]));
    auto t = __builtin_amdgcn_permlane32_swap(__float_as_uint(x), __float_as_uint(x), false, false); return fmaxf(__uint_as_float(t[0]), __uint_as_float(t[1])); }
__device__ __forceinline__ float xq_sum(float x) {
    auto s = __builtin_amdgcn_permlane16_swap(__float_as_uint(x), __float_as_uint(x), false, false); x = __uint_as_float(s[0]) + __uint_as_float(s[1]);
    auto t = __builtin_amdgcn_permlane32_swap(__float_as_uint(x), __float_as_uint(x), false, false); return __uint_as_float(t[0]) + __uint_as_float(t[1]); }
#define NA_LOAD(count_, GROW_EXPR) do { const int kk = tid >> 1, role = tid & 1; if (kk < (count_)) { const size_t grow = (size_t)(GROW_EXPR); \
        GAS const v4u* src = (GAS const v4u*)(P + grow * NA_N + (role ? 2 * DM : DM) + h * 32); \
        _Pragma("unroll") for (int t_ = 0; t_ < 4; ++t_) x[t_] = src[t_]; } } while (0)
#define NA_STORE(count_, SLOT_EXPR) do { const int kk = tid >> 1, role = tid & 1; if (kk < (count_)) { const int slot = (SLOT_EXPR); \
        if (role == 0) { float kf[32]; float ss = 0.f; \
            _Pragma("unroll") for (int t_ = 0; t_ < 4; ++t_) { kf[8 * t_ + 0] = bflo(x[t_].x); kf[8 * t_ + 1] = bfhi(x[t_].x); kf[8 * t_ + 2] = bflo(x[t_].y); kf[8 * t_ + 3] = bfhi(x[t_].y); \
                kf[8 * t_ + 4] = bflo(x[t_].z); kf[8 * t_ + 5] = bfhi(x[t_].z); kf[8 * t_ + 6] = bflo(x[t_].w); kf[8 * t_ + 7] = bfhi(x[t_].w); } \
            _Pragma("unroll") for (int t_ = 0; t_ < 32; ++t_) ss += kf[t_] * kf[t_]; \
            const float rn = __builtin_amdgcn_rsqf(ss * (1.f / 32.f) + RMS_EPS); \
            _Pragma("unroll") for (int t_ = 0; t_ < 4; ++t_) *(LAS v4u*)(KI + slot * NKS + 8 * t_) = (v4u){pk2(kf[8 * t_] * rn * kg[8 * t_], kf[8 * t_ + 1] * rn * kg[8 * t_ + 1]), pk2(kf[8 * t_ + 2] * rn * kg[8 * t_ + 2], kf[8 * t_ + 3] * rn * kg[8 * t_ + 3]), \
                pk2(kf[8 * t_ + 4] * rn * kg[8 * t_ + 4], kf[8 * t_ + 5] * rn * kg[8 * t_ + 5]), pk2(kf[8 * t_ + 6] * rn * kg[8 * t_ + 6], kf[8 * t_ + 7] * rn * kg[8 * t_ + 7])}; \
        } else { \
            _Pragma("unroll") for (int t_ = 0; t_ < 4; ++t_) { VTI[(8 * t_ + 0) * NVS + slot] = (bf16)(x[t_].x & 0xffffu); VTI[(8 * t_ + 1) * NVS + slot] = (bf16)(x[t_].x >> 16); VTI[(8 * t_ + 2) * NVS + slot] = (bf16)(x[t_].y & 0xffffu); VTI[(8 * t_ + 3) * NVS + slot] = (bf16)(x[t_].y >> 16); \
                VTI[(8 * t_ + 4) * NVS + slot] = (bf16)(x[t_].z & 0xffffu); VTI[(8 * t_ + 5) * NVS + slot] = (bf16)(x[t_].z >> 16); VTI[(8 * t_ + 6) * NVS + slot] = (bf16)(x[t_].w & 0xffffu); VTI[(8 * t_ + 7) * NVS + slot] = (bf16)(x[t_].w >> 16); } \
        } } } while (0)

__device__ __forceinline__ void na_qblock(gcb P, gb Oo, LAS bf16* KI, LAS bf16* VTI, LAS float* bias, const LAS float* qg, int h, int qrow0, bool lat, int r, int cb, int lane, bool dry, v4u qraw, unsigned (&tbl)[32], int& tbl_d) {
    const int l15 = lane & 15, q4 = lane >> 4;
    hb8 qf;
    {
        const v4u x = qraw;
        float f[8] = {bflo(x.x), bfhi(x.x), bflo(x.y), bfhi(x.y), bflo(x.z), bfhi(x.z), bflo(x.w), bfhi(x.w)};
        float ss = 0.f;
#pragma unroll
        for (int t = 0; t < 8; ++t) ss += f[t] * f[t];
        ss = xq_sum(ss);
        const float rn = __builtin_amdgcn_rsqf(ss * (1.f / 32.f) + RMS_EPS) * (0.17677669529663687f * 1.4426950408889634f);
        { const f32x4 g0 = *(const LAS f32x4*)(qg + q4 * 8), g1 = *(const LAS f32x4*)(qg + q4 * 8 + 4); const float gq[8] = {g0.x, g0.y, g0.z, g0.w, g1.x, g1.y, g1.z, g1.w};
#pragma unroll
        for (int t = 0; t < 8; ++t) f[t] = f[t] * rn * gq[t]; }
        const v4u pk = (v4u){pk2(f[0], f[1]), pk2(f[2], f[3]), pk2(f[4], f[5]), pk2(f[6], f[7])};
        qf = __builtin_bit_cast(hb8, pk);
    }
    int r0 = r - 4; r0 = r0 < 0 ? 0 : (r0 > 24 ? 24 : r0);
    int kc0 = 16 * cb - 8; kc0 = kc0 < 0 ? 0 : (kc0 > 32 ? 32 : kc0);
    const int qcol = 16 * cb + l15;
    int c0 = qcol - 8; c0 = c0 < 0 ? 0 : (c0 > 48 ? 48 : c0);
    if (lat && (r - r0) != tbl_d) {
        tbl_d = r - r0;
#pragma unroll
        for (int ch = 0; ch < 2; ++ch)
#pragma unroll
            for (int tl = 0; tl < 8; ++tl) {
                const int kcol0 = kc0 + 16 * (tl & 1) + 4 * q4;
                const LAS float* bp = bias + (4 * ch + (tl >> 1) - tbl_d + 7) * 31;
                float tv[4];
#pragma unroll
                for (int i = 0; i < 4; ++i) { const int kcol = kcol0 + i; const bool ok = (kcol >= c0) && (kcol < c0 + 16);
                    int dc = kcol - qcol + 15; dc = dc < 0 ? 0 : (dc > 30 ? 30 : dc);
                    tv[i] = ok ? bp[dc] * 1.4426950408889634f : -INFINITY; }
                tbl[ch * 16 + tl * 2 + 0] = pk2(tv[0], tv[1]); tbl[ch * 16 + tl * 2 + 1] = pk2(tv[2], tv[3]);
            }
    }
    float mrun = -INFINITY, lrun = 0.f;
    f32x4 Oa[2] = {(f32x4){0.f, 0.f, 0.f, 0.f}, (f32x4){0.f, 0.f, 0.f, 0.f}};
#define NA_CHUNK(CH, LAT) do { \
        f32x4 sc[8]; int kbase[8]; \
        _Pragma("unroll") for (int tl = 0; tl < 8; ++tl) { \
            const int krow = r0 + 4 * (CH) + (tl >> 1); \
            kbase[tl] = (LAT) ? ((krow % 12) * 64 + kc0 + 16 * (tl & 1)) : (768 + ((CH) - 2) * 128 + tl * 16); \
            const hb8 fa = *(const LAS hb8*)(KI + (kbase[tl] + l15) * NKS + q4 * 8); \
            sc[tl] = MFMA16(fa, qf, ((f32x4){0.f, 0.f, 0.f, 0.f})); } \
        float mx = -INFINITY; \
        if (LAT) { \
            _Pragma("unroll") for (int tl = 0; tl < 8; ++tl) { \
                _Pragma("unroll") for (int i = 0; i < 4; ++i) { const unsigned tw = tbl[((LAT) ? (CH) : 0) * 16 + tl * 2 + (i >> 1)]; const float s_ = sc[tl][i] + ((i & 1) ? bfhi(tw) : bflo(tw)); sc[tl][i] = s_; mx = fmaxf(mx, s_); } } \
        } else { \
            _Pragma("unroll") for (int tl = 0; tl < 8; ++tl) mx = fmaxf(mx, fmaxf(fmaxf(sc[tl].x, sc[tl].y), fmaxf(sc[tl].z, sc[tl].w))); } \
        mx = xq_max(mx); \
        const float mnew = fmaxf(mrun, mx), corr = __builtin_amdgcn_exp2f(mrun - mnew); \
        lrun *= corr; Oa[0] = Oa[0] * corr; Oa[1] = Oa[1] * corr; mrun = mnew; \
        _Pragma("unroll") for (int ks = 0; ks < 4; ++ks) { \
            f32x4 p0, p1; \
            _Pragma("unroll") for (int i = 0; i < 4; ++i) { p0[i] = __builtin_amdgcn_exp2f(sc[2 * ks][i] - mnew); p1[i] = __builtin_amdgcn_exp2f(sc[2 * ks + 1][i] - mnew); } \
            lrun += (p0.x + p0.y) + (p0.z + p0.w) + (p1.x + p1.y) + (p1.z + p1.w); \
            const v4u pk = (v4u){pk2(p0.x, p0.y), pk2(p0.z, p0.w), pk2(p1.x, p1.y), pk2(p1.z, p1.w)}; \
            const hb8 fb = __builtin_bit_cast(hb8, pk); \
            _Pragma("unroll") for (int dt = 0; dt < 2; ++dt) { \
                const v2u a0 = *(const LAS v2u*)(VTI + (dt * 16 + l15) * NVS + kbase[2 * ks] + 4 * q4), a1 = *(const LAS v2u*)(VTI + (dt * 16 + l15) * NVS + kbase[2 * ks + 1] + 4 * q4); \
                const v4u av = (v4u){a0.x, a0.y, a1.x, a1.y}; \
                Oa[dt] = MFMA16(__builtin_bit_cast(hb8, av), fb, Oa[dt]); } } } while (0)
    if (lat) { NA_CHUNK(0, true); asm volatile("" ::: "memory"); NA_CHUNK(1, true); asm volatile("" ::: "memory"); }
#pragma unroll 1
    for (int ch = 2; ch < 4; ++ch) NA_CHUNK(ch, false);
#undef NA_CHUNK
    const float inv = 1.f / xq_sum(lrun);
    { const f32x4 o0 = Oa[0] * inv, o1 = Oa[1] * inv;
      const unsigned a0 = pk2(o0.x, o0.y), a1 = pk2(o0.z, o0.w), b0 = pk2(o1.x, o1.y), b1 = pk2(o1.z, o1.w);
      auto s0 = __builtin_amdgcn_permlane16_swap(a0, b0, false, false); auto s1 = __builtin_amdgcn_permlane16_swap(a1, b1, false, false);
      const int col = (q4 & 1) ? 16 + 4 * (q4 - 1) : 4 * q4;
      if (!dry) *(GAS v4u*)(Oo + (size_t)(qrow0 + l15) * DM + h * 32 + col) = (v4u){s0[0], s1[0], s0[1], s1[1]}; }
}

__device__ __forceinline__ void phase_na2(Frame& F, bool ctx_out, bool dry = false) {
    FRAME_TID(F);
    gcb P = (gcb)(F.ws + WS_P); gb Oo = (gb)(F.ws + WS_O);
    gcf qgg = F.in[I_NAQG], kg = F.in[I_NAKG], rpb = F.in[I_NARPB];
    LAS float* qg = (LAS float*)(F.lds + 150016);
    LAS bf16* KI = (LAS bf16*)(F.lds + NA_KI); LAS bf16* VTI = (LAS bf16*)(F.lds + NA_VTI); LAS float* bias = (LAS float*)(F.lds + NA_BIAS);
    const int tid_ = F.tid, lane_ = F.lane, wave = F.wave;
#define NA_QLOAD(qrow0_) (*(GAS const v4u*)(P + (size_t)((qrow0_) + (lane & 15)) * NA_N + h * 32 + (lane >> 4) * 8))
    for (int item = blockIdx.x; item < NB * 64; item += F.G) {
        const int b = item >> 6, h = item & 63;
        int tid = tid_, lane = lane_; asm volatile("" : "+v"(tid), "+v"(lane));
        v4u x[4];
        unsigned tbl[32]; int tbl_d = -100;
        LDS_BARRIER();
        for (int idx = tid; idx < 15 * 31; idx += NTHREADS) bias[idx] = rpb[h * 465 + idx];
        if (tid < 32) qg[tid] = qgg[tid];
        NA_LOAD(256, b * TCX + kk); NA_STORE(256, 768 + kk);
        NA_LOAD(256, ROWS_C + b * TL + kk); NA_STORE(256, kk);
        NA_LOAD(256, ROWS_C + b * TL + 256 + kk);
        LDS_BARRIER();
        if (ctx_out) {
            v4u qn = NA_QLOAD(b * TCX + wave * 16);
#pragma unroll 1
            for (int qb = wave; qb < 16; qb += 8) { const v4u qc = qn; if (qb + 8 < 16) qn = NA_QLOAD(b * TCX + (qb + 8) * 16);
                na_qblock(P, Oo, KI, VTI, bias, qg, h, b * TCX + qb * 16, false, 0, 0, lane, dry, qc, tbl, tbl_d); }
        }
        v4u qn = NA_QLOAD(ROWS_C + b * TL + (wave >> 2) * 64 + (wave & 3) * 16);
        NA_STORE(256, 256 + kk);
        int staged_hi = 7;
#pragma unroll 1
        for (int rg = 0; rg < 8; ++rg) {
            int nhi = 4 * (rg + 1) - 1; nhi = nhi > 24 ? 24 : nhi; nhi += 7;
            const int r1 = staged_hi + 1, ncnt = (rg < 7) ? (nhi - staged_hi) * 64 : 0;
            NA_LOAD(ncnt, ROWS_C + b * TL + r1 * 64 + kk);
            LDS_BARRIER();
            {
#pragma unroll 1
                for (int qb = wave; qb < 16; qb += 8) { const int r = rg * 4 + (qb >> 2), cb = qb & 3; const v4u qc = qn;
                    { const bool more = qb + 8 < 16; const int rgn = more ? rg : rg + 1, qbn = more ? qb + 8 : wave;
                      if (more || rg < 7) qn = NA_QLOAD(ROWS_C + b * TL + (rgn * 4 + (qbn >> 2)) * 64 + (qbn & 3) * 16); }
                    na_qblock(P, Oo, KI, VTI, bias, qg, h, ROWS_C + b * TL + r * 64 + cb * 16, true, r, cb, lane, dry, qc, tbl, tbl_d); }
            }
            LDS_BARRIER();
            NA_STORE(ncnt, ((r1 + (kk >> 6)) % 12) * 64 + (kk & 63));
            staged_hi = (rg < 7) ? nhi : staged_hi;
        }
    }
#undef NA_QLOAD
}

constexpr int NPH = 1 + 8 * DEPTH;
#define IN(k) (lo <= (k) && (k) < hi)
#define SEAM(k) do { if (IN(k) && IN((k) + 1)) { FRAME_TID(F); xcd_barrier(bar, F.tid); if (PROBE_BAR) xcd_barrier(bar, F.tid); } } while (0)
template <int L> __device__ __forceinline__ void layer_body(Frame& F, const Args& args, unsigned char* const wsg, const int lo, const int hi, const XcdBarrier& bar) {
        const int base = 1 + 8 * L, m = L % 3, j = L / 3;
        constexpr bool last = (L == DEPTH - 1);
        gcf modL = (gcf)(F.ws + WS_MOD) + (size_t)L * 17 * NMODC;
        _Float16* const X16A = (_Float16*)args.out; _Float16* const X16B = (_Float16*)(wsg + WS_O);
        _Float16* const X16mid = last ? X16B : X16A;
        const int NinP = (m == 0) ? HG_N : (m == 1) ? GDN_NP : NA_N;
        const int row_lo2 = last ? ROWS_C : 0;
        const int pm02 = row_lo2 / 256;

        if (IN(base + 0)) {
#if PROBE_THIN == 2
            phase_norm<(L != 0)>(F, F.in[I_NMG] + L * DM, modL, 0, F.in[I_X], F.in[I_CTX], (GAS const _Float16*)X16A, 0, M_ALL);
            __syncthreads();
#endif
#if PROBE_THIN == 3
            phase_wprep(F, L);
            __syncthreads();
#endif
            phase_wprep(F, L);
            phase_norm<(L != 0)>(F, F.in[I_NMG] + L * DM, modL, 0, F.in[I_X], F.in[I_CTX], (GAS const _Float16*)X16A, 0, M_ALL);
            SEAM(base + 0);
        }
        if (IN(base + 1)) {
            pg8::Gemm g{(const pg8::bf16_t*)(wsg + WS_H), (const pg8::bf16_t*)(wsg + WS_WT_IN), M_ALL, NinP, DM, DM};
            pg8::StaticOrder S; S.init(M_ALL, NinP, F.G, (int)blockIdx.x);
            pg8::EpiStore E{(pg8::bf16_t*)(wsg + WS_P), NinP, (m == 0) ? 0 : 0, (m == 0) ? 8 : 0, (m == 2) ? 0 : 32, (m == 0) ? 40 : (m == 1) ? 48 : 0};
            pg8::gemm_phase<pg8::EpiStore, pg8::StaticOrder, true, true>(F.lds, g, S, E, F.wave);
#if PROBE_GEMM == 8
            { __syncthreads(); pg8::EpiNull E0{(pg8::bf16_t*)(wsg + WS_O)}; pg8::ZeroOrder Z; Z.init(M_ALL, NinP, F.G, (int)blockIdx.x); pg8::gemm_phase<pg8::EpiNull, pg8::ZeroOrder, true, true>(F.lds, g, Z, E0, F.wave); }
#endif
#if PROBE_GEMM == 9
            { __syncthreads(); pg8::EpiNull E0{(pg8::bf16_t*)(wsg + WS_O)}; pg8::gemm_phase<pg8::EpiNull, pg8::StaticOrder, true, true>(F.lds, g, S, E0, F.wave); }
#endif
#if PROBE_GEMM == 1
            __syncthreads(); pg8::gemm_phase<pg8::EpiStore, pg8::StaticOrder, true, true>(F.lds, g, S, E, F.wave);
#endif
#if PROBE_GEMM == 5
            { __syncthreads(); pg8::EpiNull E0{(pg8::bf16_t*)(wsg + WS_O)}; pg8::gemm_phase<pg8::EpiNull, pg8::StaticOrder, true, true>(F.lds, g, S, E0, F.wave); }
#endif
            SEAM(base + 1);
        }
        if (IN(base + 2)) {
#if PROBE_MIX == 1
            if (m == 0) { phase_hg2(F, j, !last, args.ph_lo == 0); __syncthreads(); }
#endif
#if PROBE_MIX == 2
            if (m == 1) { phase_gdn2(F, !last, args.ph_lo == 0); __syncthreads(); }
#endif
#if PROBE_MIX == 3
            if (m == 2) { phase_na2(F, !last, args.ph_lo == 0); __syncthreads(); }
#endif
            if (m == 0) phase_hg2(F, j, !last);
            else if (m == 1) phase_gdn2(F, !last);
            else phase_na2(F, !last);
            SEAM(base + 2);
        }
        if (IN(base + 3)) {
            const pg8::bf16_t* A = (m == 2) ? (const pg8::bf16_t*)(wsg + WS_O) : (const pg8::bf16_t*)(wsg + WS_P) + 4 * DM;
            const int lda = (m == 0) ? HG_N : (m == 1) ? GDN_NP : DM, Kout = (m == 1) ? 2 * DM : DM;
            const int Mr = M_ALL - row_lo2;
            pg8::Gemm g{A + (size_t)row_lo2 * lda, (const pg8::bf16_t*)(wsg + WS_WT_OUT), Mr, DM, Kout, lda};
            pg8::StaticOrder S; S.init(Mr, DM, F.G, (int)blockIdx.x);
            typedef pg8::EpiResidT<(L != 0), true> EpiO;
            EpiO E{(const float*)args.in[I_X], (const float*)args.in[I_CTX], X16A, X16mid, nullptr, (const float*)modL + 2 * DM, pm02, 0};
            pg8::gemm_phase<EpiO, pg8::StaticOrder, true, true>(F.lds, g, S, E, F.wave);
            SEAM(base + 3);
        }
        if (IN(base + 4)) {
#if PROBE_THIN == 2
            phase_norm<true>(F, F.in[I_NFG] + L * DM, modL, 3, F.in[I_X], F.in[I_CTX], (GAS const _Float16*)X16mid, row_lo2, M_ALL);
#endif
            phase_norm<true>(F, F.in[I_NFG] + L * DM, modL, 3, F.in[I_X], F.in[I_CTX], (GAS const _Float16*)X16mid, row_lo2, M_ALL);
            SEAM(base + 4);
        }
        if (IN(base + 5)) {
            const int Mr = M_ALL - row_lo2;
            pg8::Gemm g{(const pg8::bf16_t*)(wsg + WS_H) + (size_t)row_lo2 * DM, (const pg8::bf16_t*)(wsg + WS_WT_UP), Mr, UP_N, DM, DM};
            pg8::StaticOrder S; S.init(Mr, UP_N, F.G, (int)blockIdx.x);
            pg8::EpiConvGate E{(pg8::bf16_t*)(wsg + WS_P) + (size_t)row_lo2 * DFF, (pg8::bf16_t*)(wsg + WS_WT_IN), args.in[I_FFNCW] + (size_t)L * 3 * UP_N, pm02};
            pg8::gemm_phase<pg8::EpiConvGate, pg8::StaticOrder, true, true>(F.lds, g, S, E, F.wave);
#if PROBE_GEMM == 2
            __syncthreads(); pg8::gemm_phase<pg8::EpiConvGate, pg8::StaticOrder, true, true>(F.lds, g, S, E, F.wave);
#endif
            SEAM(base + 5);
        }
        if (IN(base + 6)) {
            phase_ffnfix(F, L, row_lo2, M_ALL);
            SEAM(base + 6);
        }
        if (IN(base + 7)) {
            const int Mr = M_ALL - row_lo2;
            pg8::Gemm g{(const pg8::bf16_t*)(wsg + WS_P) + (size_t)row_lo2 * DFF, (const pg8::bf16_t*)(wsg + WS_WT_DN), Mr, DM, DFF, DFF};
            pg8::StaticOrder S; S.init(Mr, DM, F.G, (int)blockIdx.x);
            typedef pg8::EpiResidT<true, !last> EpiD;
            EpiD E{nullptr, nullptr, X16mid, X16A, args.out, (const float*)(wsg + WS_MOD) + (size_t)L * 17 * NMODC + 5 * DM, pm02, 0};
            pg8::gemm_phase<EpiD, pg8::StaticOrder, true, true>(F.lds, g, S, E, F.wave);
            SEAM(base + 7);
        }
    }
#undef IN
#undef SEAM
__global__ void __launch_bounds__(NTHREADS, 2) fwd(Args args) {
    extern __shared__ __attribute__((aligned(16))) unsigned char lds_raw[];
    Frame F;
    F.lds = (LAS unsigned char*)lds_raw;
    F.wave = __builtin_amdgcn_readfirstlane((int)threadIdx.x >> 6); FRAME_TID(F);
    F.G = gridDim.x; F.gw = blockIdx.x * NWAVES + F.wave; F.NGW = F.G * NWAVES;
#pragma unroll
    for (int i = 0; i < 26; ++i) F.in[i] = (gcf)args.in[i];
    F.out = (gf)args.out; F.ws = (GAS unsigned char*)args.ws;
    unsigned char* const wsg = args.ws;
    volatile LAS unsigned* MISC = (volatile LAS unsigned*)(F.lds + MISC_OFF);
    if (F.tid < 64) MISC[F.tid] = 0u;
    __syncthreads();
    const int lo = args.ph_lo, hi = args.ph_hi;
    XcdBarrier bar; bar.bar = (unsigned*)(wsg + WS_CTL) + CW_BAR; bar.x = 0; bar.st = MISC + 8;
    if (hi - lo > 1) bar = xcd_barrier_post((unsigned*)(wsg + WS_CTL) + CW_BAR, MISC + 8, F.tid);
#define IN(k) (lo <= (k) && (k) < hi)
#define SEAM(k) do { if (IN(k) && IN((k) + 1)) { FRAME_TID(F); xcd_barrier(bar, F.tid); if (PROBE_BAR) xcd_barrier(bar, F.tid); } } while (0)

#if PROBE_THIN == 4
    if (IN(0)) { phase_mod(F); __syncthreads(); }
#endif
    if (IN(0)) { phase_mod(F); SEAM(0); }

    layer_body<0>(F, args, wsg, lo, hi, bar);
    layer_body<1>(F, args, wsg, lo, hi, bar);
    layer_body<2>(F, args, wsg, lo, hi, bar);
    layer_body<3>(F, args, wsg, lo, hi, bar);
#undef IN
#undef SEAM
}

extern "C" void kernel_launch(void* const* d_in, const int* in_sizes, int n_in, void* d_out, int out_size, void* d_ws, size_t ws_size, hipStream_t stream) {
    static int grid = 0;
    if (grid == 0) {
        if (n_in != 26 || in_sizes[0] != ROWS_L * DM || out_size != ROWS_L * DM || ws_size < WS_END) {
            fprintf(stderr, "kernel_launch: unexpected shapes/workspace: n_in %d in0 %d out %d ws %zu (need %zu)\n", n_in, n_in > 0 ? in_sizes[0] : -1, out_size, ws_size, (size_t)WS_END); grid = -1; return; }
        int dev = 0, cus = 0;
        if (hipGetDevice(&dev) != hipSuccess || hipDeviceGetAttribute(&cus, hipDeviceAttributeMultiprocessorCount, dev) != hipSuccess) { grid = -1; return; }
        if (hipFuncSetAttribute((const void*)fwd, hipFuncAttributeMaxDynamicSharedMemorySize, LDS_BYTES) != hipSuccess) { fprintf(stderr, "kernel_launch: hipFuncSetAttribute failed\n"); grid = -1; return; }
        int per_cu = 0;
        if (hipOccupancyMaxActiveBlocksPerMultiprocessor(&per_cu, (const void*)fwd, NTHREADS, LDS_BYTES) != hipSuccess || per_cu < 1) fprintf(stderr, "kernel_launch: occupancy query reports %d\n", per_cu);
        (void)hipGetLastError();
        grid = cus;
    }
    if (grid < 0) return;
    if (hipMemsetAsync((char*)d_ws + WS_CTL, 0, CTL_ZERO_BYTES, stream) != hipSuccess) return;
    Args a{};
    for (int i = 0; i < 26; ++i) a.in[i] = (const float*)d_in[i];
    a.out = (float*)d_out; a.ws = (unsigned char*)d_ws;
#if MK_ONE_LAUNCH
    a.ph_lo = 0; a.ph_hi = NPH;
    hipLaunchKernelGGL(fwd, dim3(grid), dim3(NTHREADS), LDS_BYTES, stream, a);
#else
    for (int p = 0; p < NPH; ++p) { a.ph_lo = p; a.ph_hi = p + 1; hipLaunchKernelGGL(fwd, dim3(grid), dim3(NTHREADS), LDS_BYTES, stream, a); }
#endif
}
```

```cpp
#include <hip/hip_runtime.h>
#include <cstdio>
#include <cstdint>

#ifndef MK_ONE_LAUNCH
#define MK_ONE_LAUNCH 1
#endif

#ifndef PROBE_MIX
#define PROBE_MIX 0
#endif
#ifndef PROBE_THIN
#define PROBE_THIN 0
#endif
#ifndef PROBE_GEMM
#define PROBE_GEMM 0
#endif
#ifndef PROBE_BAR
#define PROBE_BAR 0
#endif
#ifndef PROBE_GDN
#define PROBE_GDN 0
#endif
namespace pg8 {
#define PG8_LAS __attribute__((address_space(3)))
typedef unsigned short bf16_t;
typedef short bf16x8 __attribute__((ext_vector_type(8)));
typedef float f32x4 __attribute__((ext_vector_type(4)));
typedef unsigned u32x4 __attribute__((ext_vector_type(4)));
constexpr int BM = 256, BK = 64, HALF = 128, HTB = HALF * BK * 2  , STAGE_BYTES = 8 * HTB, NXCD = 8, WGM = 4;

__host__ __device__ __forceinline__ int lds_byte(int r, int c) { const int st = (r >> 4) * 2 + (c >> 5), rr = r & 15, cc = c & 31, ob = rr * 64 + cc * 2; return st * 1024 + (ob ^ (((ob >> 9) & 1) << 5)); }
__host__ __device__ __forceinline__ void stage_rc(int b, int& R, int& C) { const int st = b / 1024, sb = b % 1024, swz = sb ^ (((sb >> 9) & 1) << 5); R = (st >> 1) * 16 + swz / 64; C = (st & 1) * 32 + (swz % 64) / 2; }
__host__ __device__ __forceinline__ int perm32(int rho) { const int n = rho >> 4, i = rho & 15; return 8 * (i >> 2) + 4 * n + (i & 3); }

__device__ __forceinline__ int lane_id_asm() { int l; asm volatile("v_mbcnt_lo_u32_b32 %0, -1, 0\n\tv_mbcnt_hi_u32_b32 %0, -1, %0" : "=v"(l)); return l; }
struct Unit { int pm, pn; };
struct Gemm { const bf16_t* A; const bf16_t* Bt; int M, N, K, lda; };

struct StaticOrder {
    int nM, nN, nwg, G, c;
    __host__ __device__ void init(int M, int N, int G_, int c_) { nM = M / BM; nN = N / BM; nwg = nM * nN; G = G_; c = c_; }
    __host__ __device__ bool next(int i, Unit& u) const {
        const long L = (long)i * G + c; if (L >= nwg) return false;
        int wgid = (int)L; { const int q = nwg / NXCD, r = nwg % NXCD, xcd = wgid % NXCD, off = wgid / NXCD; wgid = (xcd < r ? xcd * (q + 1) : r * (q + 1) + (xcd - r) * q) + off; }
        const int nig = WGM * nN, gid = wgid / nig, fm = gid * WGM, gsz = (nM - fm) < WGM ? (nM - fm) : WGM;
        u.pm = fm + ((wgid % nig) % gsz); u.pn = (wgid % nig) / gsz; return true;
    }
    __device__ __forceinline__ void a_ready(const Unit&) const {}
    __device__ __forceinline__ void done(const Unit&) const {}
};

struct ZeroOrder : StaticOrder {
    __host__ __device__ bool next(int i, Unit& u) const { const bool ok = StaticOrder::next(i, u); u.pm = 0; u.pn = 0; return ok; }
};

__device__ __forceinline__ unsigned cvt_pk_bf16(float lo, float hi) { unsigned r; asm volatile("v_cvt_pk_bf16_f32 %0, %1, %2" : "=v"(r) : "v"(lo), "v"(hi)); return r; }
typedef float f32x2 __attribute__((ext_vector_type(2)));

struct EpiStore {
    static constexpr bool PERM = true, AFTER_DRAIN = false;
    bf16_t* O; int ldc; int a0lo, a0hi, a1lo, a1hi;
    __device__ __forceinline__ void operator()(const f32x4 (&acc)[2][2][4][2], const Unit& u, int wr, int wc, int fr, int fq) const {
        const int row0 = u.pm * BM + wr * 64 + fr; const int col0 = u.pn * BM + wc * 32 + 8 * fq;
        const bool act = (u.pn >= a0lo && u.pn < a0hi) || (u.pn >= a1lo && u.pn < a1hi);
#pragma unroll
        for (int ai = 0; ai < 2; ++ai)
#pragma unroll
            for (int m = 0; m < 4; ++m) { bf16_t* rowp = O + (size_t)(row0 + ai * HALF + m * 16) * ldc + col0;
#pragma unroll
                for (int bj = 0; bj < 2; ++bj) { f32x4 v0 = acc[ai][bj][m][0], v1 = acc[ai][bj][m][1];
                    if (act) {
#pragma unroll
                        for (int e = 0; e < 4; ++e) { v0[e] = v0[e] * __builtin_amdgcn_rcpf(1.f + __expf(-v0[e])); v1[e] = v1[e] * __builtin_amdgcn_rcpf(1.f + __expf(-v1[e])); } }
                    u32x4 w; w.x = cvt_pk_bf16(v0[0], v0[1]); w.y = cvt_pk_bf16(v0[2], v0[3]); w.z = cvt_pk_bf16(v1[0], v1[1]); w.w = cvt_pk_bf16(v1[2], v1[3]);
                    *(u32x4*)(rowp + bj * HALF) = w; } }
    }
};
typedef _Float16 h16x4 __attribute__((ext_vector_type(4)));
typedef unsigned u32x2 __attribute__((ext_vector_type(2)));
__device__ __forceinline__ u32x2 f4_to_h4(f32x4 v) { return __builtin_bit_cast(u32x2, __builtin_convertvector(v, h16x4)); }
__device__ __forceinline__ f32x4 h4_to_f4(u32x2 w) { return __builtin_convertvector(__builtin_bit_cast(h16x4, w), f32x4); }
template <bool IN16, bool OUT16>
struct EpiResidT {
    static constexpr bool PERM = true, AFTER_DRAIN = false;
    const float* rl; const float* rc; const _Float16* xin; _Float16* xout; float* ol; const float* gate; int pm0; int dry;
    __device__ __forceinline__ void operator()(const f32x4 (&acc)[2][2][4][2], const Unit& u, int wr, int wc, int fr, int fq) const {
        const int pmg = u.pm + pm0; const bool isctx = pmg < 16;
        const int mr = isctx ? 16 : ((pmg - 16) >> 3);
        const size_t urow0 = (size_t)pmg * 256 + wr * 64 + fr;
        const size_t lrow0 = isctx ? urow0 : urow0 - 4096;
        const float* rin = isctx ? rc : rl;
        const int col0 = u.pn * BM + wc * 32 + 8 * fq;
        f32x4 gv[2][2];
#pragma unroll
        for (int bj = 0; bj < 2; ++bj)
#pragma unroll
            for (int n = 0; n < 2; ++n) gv[bj][n] = *(const f32x4*)(gate + (size_t)mr * 12288 + col0 + bj * HALF + 4 * n);
#pragma unroll
        for (int ai = 0; ai < 2; ++ai) {
            f32x4 r[4][2][2];
            if constexpr (IN16) {
                u32x4 rh[4][2];
#pragma unroll
                for (int m = 0; m < 4; ++m)
#pragma unroll
                    for (int bj = 0; bj < 2; ++bj) rh[m][bj] = *(const u32x4*)(xin + (urow0 + ai * HALF + m * 16) * 2048 + col0 + bj * HALF);
#pragma unroll
                for (int m = 0; m < 4; ++m)
#pragma unroll
                    for (int bj = 0; bj < 2; ++bj) { r[m][bj][0] = h4_to_f4((u32x2){rh[m][bj].x, rh[m][bj].y}); r[m][bj][1] = h4_to_f4((u32x2){rh[m][bj].z, rh[m][bj].w}); }
            } else {
#pragma unroll
                for (int m = 0; m < 4; ++m)
#pragma unroll
                    for (int bj = 0; bj < 2; ++bj)
#pragma unroll
                        for (int n = 0; n < 2; ++n) r[m][bj][n] = *(const f32x4*)(rin + (lrow0 + ai * HALF + m * 16) * 2048 + col0 + bj * HALF + 4 * n);
            }
#pragma unroll
            for (int m = 0; m < 4; ++m)
#pragma unroll
                for (int bj = 0; bj < 2; ++bj) {
                    const f32x4 v0 = r[m][bj][0] + gv[bj][0] * acc[ai][bj][m][0], v1 = r[m][bj][1] + gv[bj][1] * acc[ai][bj][m][1];
                    if (!dry || v0.x == 1.2345e30f) {
                        if constexpr (OUT16) { const u32x2 h0 = f4_to_h4(v0), h1 = f4_to_h4(v1); *(u32x4*)(xout + (urow0 + ai * HALF + m * 16) * 2048 + col0 + bj * HALF) = (u32x4){h0.x, h0.y, h1.x, h1.y}; }
                        else { float* op = ol + (lrow0 + ai * HALF + m * 16) * 2048 + col0 + bj * HALF; *(f32x4*)op = v0; *(f32x4*)(op + 4) = v1; }
                    }
                }
        }
    }
};

template <int CTRL> __device__ __forceinline__ float dppmov(float x) { return __builtin_bit_cast(float, __builtin_amdgcn_mov_dpp(__builtin_bit_cast(int, x), CTRL, 0xf, 0xf, true)); }
template <int CTRL> __device__ __forceinline__ float dppupd(float old, float x) { return __builtin_bit_cast(float, __builtin_amdgcn_update_dpp(__builtin_bit_cast(int, old), __builtin_bit_cast(int, x), CTRL, 0xf, 0xf, false)); }
struct EpiConvGate {
    static constexpr bool PERM = true, AFTER_DRAIN = false;
    bf16_t* G; bf16_t* SIDE; const float* cw; int pm0;
    __device__ __forceinline__ void operator()(const f32x4 (&acc)[2][2][4][2], const Unit& u, int wr, int wc, int fr, int fq) const {
        const int cc0 = wc * 32 + 8 * fq;
        const int jg0 = u.pn * 128 + cc0;
        f32x4 wa2[2][3], wb2[2][3];
#pragma unroll
        for (int n = 0; n < 2; ++n)
#pragma unroll
            for (int t = 0; t < 3; ++t) { wa2[n][t] = *(const f32x4*)(cw + t * 11008 + jg0 + 4 * n); wb2[n][t] = *(const f32x4*)(cw + t * 11008 + 5504 + jg0 + 4 * n); }
        asm volatile("" :: "v"(wa2[0][0]), "v"(wa2[0][1]), "v"(wa2[0][2]), "v"(wb2[0][0]), "v"(wb2[0][1]), "v"(wb2[0][2]), "v"(wa2[1][0]), "v"(wa2[1][1]), "v"(wa2[1][2]), "v"(wb2[1][0]), "v"(wb2[1][1]), "v"(wb2[1][2]));
#pragma unroll
        for (int ai = 0; ai < 2; ++ai)
#pragma unroll
            for (int m = 0; m < 4; ++m) {
                unsigned gq[4];
#pragma unroll
                for (int n = 0; n < 2; ++n) {
                    const f32x4 (&wa)[3] = wa2[n]; const f32x4 (&wb)[3] = wb2[n];
                    f32x4 ga;
#pragma unroll
                    for (int e = 0; e < 4; ++e) {
                        const float ac = acc[ai][0][m][n][e], bc = acc[ai][1][m][n][e];
                        const float apo = (m > 0) ? dppmov<0x121>(acc[ai][0][m > 0 ? m - 1 : 0][n][e]) : 0.f, bpo = (m > 0) ? dppmov<0x121>(acc[ai][1][m > 0 ? m - 1 : 0][n][e]) : 0.f;
                        const float ano = (m < 3) ? dppmov<0x12F>(acc[ai][0][m < 3 ? m + 1 : 3][n][e]) : 0.f, bno = (m < 3) ? dppmov<0x12F>(acc[ai][1][m < 3 ? m + 1 : 3][n][e]) : 0.f;
                        const float ap = dppupd<0x111>(apo, ac), bp = dppupd<0x111>(bpo, bc);
                        const float an = dppupd<0x101>(ano, ac), bn = dppupd<0x101>(bno, bc);
                        const float a = ap * wa[0][e] + ac * wa[1][e] + an * wa[2][e], b = bp * wb[0][e] + bc * wb[1][e] + bn * wb[2][e];
                        ga[e] = a * __builtin_amdgcn_rcpf(1.f + __expf(-a)) * b;
                    }
                    gq[2 * n] = cvt_pk_bf16(ga[0], ga[1]); gq[2 * n + 1] = cvt_pk_bf16(ga[2], ga[3]);
                }
                const int sl = 16 * m + fr;
                const size_t row = (size_t)u.pm * BM + ai * HALF + wr * 64 + sl;
                if (sl != 0 && sl != 63) *(u32x4*)(G + row * 5504 + jg0) = (u32x4){gq[0], gq[1], gq[2], gq[3]};
                if (sl <= 1 || sl >= 62) {
                    const int which = (sl <= 1) ? sl : sl - 60;
                    const size_t strip = (size_t)(u.pm + pm0) * 4 + ai * 2 + wr;
                    bf16_t* sp = SIDE + (strip * 4 + which) * 11008 + u.pn * BM + cc0;
                    *(u32x4*)sp = (u32x4){cvt_pk_bf16(acc[ai][0][m][0][0], acc[ai][0][m][0][1]), cvt_pk_bf16(acc[ai][0][m][0][2], acc[ai][0][m][0][3]), cvt_pk_bf16(acc[ai][0][m][1][0], acc[ai][0][m][1][1]), cvt_pk_bf16(acc[ai][0][m][1][2], acc[ai][0][m][1][3])};
                    *(u32x4*)(sp + HALF) = (u32x4){cvt_pk_bf16(acc[ai][1][m][0][0], acc[ai][1][m][0][1]), cvt_pk_bf16(acc[ai][1][m][0][2], acc[ai][1][m][0][3]), cvt_pk_bf16(acc[ai][1][m][1][0], acc[ai][1][m][1][1]), cvt_pk_bf16(acc[ai][1][m][1][2], acc[ai][1][m][1][3])};
                }
            }
    }
};


struct EpiNull {
    static constexpr bool PERM = true, AFTER_DRAIN = false;
    bf16_t* O;
    __device__ __forceinline__ void operator()(const f32x4 (&acc)[2][2][4][2], const Unit& u, int wr, int wc, int fr, int fq) const {
        f32x4 s = (f32x4){0.f, 0.f, 0.f, 0.f};
#pragma unroll
        for (int ai = 0; ai < 2; ++ai)
#pragma unroll
            for (int bj = 0; bj < 2; ++bj)
#pragma unroll
                for (int m = 0; m < 4; ++m)
#pragma unroll
                    for (int n = 0; n < 2; ++n) s = s + acc[ai][bj][m][n];
        if (s.x == 1.2345e30f) *(f32x4*)(O + (size_t)u.pm * 8) = s;
    }
};
template <class Epi, class Sched, bool ALIGN_EPI = false, bool SP2 = false>
__device__ __forceinline__ void gemm_phase(PG8_LAS unsigned char* lds, const Gemm g, const Sched& S, const Epi& E, const int wave_in) {
    const int lane = lane_id_asm(), wid = __builtin_amdgcn_readfirstlane(wave_in), tid = wid * 64 + lane, wr = wid >> 2, wc = wid & 3, fr = lane & 15, fq = lane >> 4;
    const int K = g.K, nt = K / BK;
    unsigned voffA[2], voffB[2];
#pragma unroll
    for (int i = 0; i < 2; ++i) { int R, C; stage_rc(tid * 16 + i * 8192, R, C); const int Rb = Epi::PERM ? ((R & ~31) + perm32(R & 31)) : R;
        voffA[i] = (unsigned)(R * g.lda + C) * 2u; voffB[i] = (unsigned)(Rb * K + C) * 2u; }
    const size_t kstep = (size_t)(BK * 2);
    const size_t hstepA = (size_t)HALF * g.lda * 2, hstepB = (size_t)HALF * K * 2;
    const size_t tstepA = 2 * hstepA, tstepB = 2 * hstepB;
    const unsigned ldsw = (unsigned)wid * 1024u;
    const int aoff = lds_byte(wr * 64 + fr, fq * 8), boff = lds_byte(wc * 32 + fr, fq * 8);
#define PG8_SA(b, h) (((b) * 2 + (h)) * HTB)
#define PG8_SB(b, h) ((4 + (b) * 2 + (h)) * HTB)
#define PG8_STAGE(bufoff, gbase, voff) do { _Pragma("unroll") for (int _i = 0; _i < 2; ++_i) \
        __builtin_amdgcn_global_load_lds((const unsigned*)((const char*)(gbase) + (voff)[_i]), (PG8_LAS unsigned*)(lds + (bufoff) + ldsw + _i * 8192), 16, 0, 0); } while (0)
#define PG8_LDA(dst, b, h) do { _Pragma("unroll") for (int m = 0; m < 4; ++m) _Pragma("unroll") for (int k = 0; k < 2; ++k) dst[m][k] = *(const PG8_LAS bf16x8*)(lds + PG8_SA(b, h) + aoff + m * 2048 + k * 1024); } while (0)
#define PG8_LDB(dst, b, h) do { _Pragma("unroll") for (int n = 0; n < 2; ++n) _Pragma("unroll") for (int k = 0; k < 2; ++k) dst[n][k] = *(const PG8_LAS bf16x8*)(lds + PG8_SB(b, h) + boff + n * 2048 + k * 1024); } while (0)
#define PG8_MMA(ai, bj, At, Bt) do { __builtin_amdgcn_s_setprio(1); _Pragma("unroll") for (int m = 0; m < 4; ++m) _Pragma("unroll") for (int n = 0; n < 2; ++n) _Pragma("unroll") for (int k = 0; k < 2; ++k) \
        acc[ai][bj][m][n] = __builtin_amdgcn_mfma_f32_16x16x32_bf16(Bt[n][k], At[m][k], acc[ai][bj][m][n], 0, 0, 0); __builtin_amdgcn_s_setprio(0); } while (0)
#define PG8_WAIT_V(n) asm volatile("s_waitcnt vmcnt(" #n ")" ::: "memory")
#define PG8_WAIT_L(n) asm volatile("s_waitcnt lgkmcnt(" #n ")" ::: "memory")
#define PG8_BAR __builtin_amdgcn_s_barrier()
#define PG8_SCHED __builtin_amdgcn_sched_barrier(0)
    Unit cur, nxt; int ui = 0;
    if (!S.next(0, cur)) return;
    f32x4 acc[2][2][4][2];
#pragma unroll
    for (int a = 0; a < 2; ++a)
#pragma unroll
        for (int b = 0; b < 2; ++b)
#pragma unroll
            for (int m = 0; m < 4; ++m)
#pragma unroll
                for (int n = 0; n < 2; ++n) acc[a][b][m][n] = (f32x4){0.f, 0.f, 0.f, 0.f};
    bf16x8 At[4][2], B0[2][2], B1[2][2];
    const char* cA = (const char*)g.A + (size_t)cur.pm * tstepA; const char* cB = (const char*)g.Bt + (size_t)cur.pn * tstepB;
    S.a_ready(cur);
    if constexpr (SP2) {
        PG8_STAGE(PG8_SB(0, 0), cB, voffB); PG8_STAGE(PG8_SB(0, 1), cB + hstepB, voffB); PG8_STAGE(PG8_SA(0, 0), cA, voffA); PG8_STAGE(PG8_SA(0, 1), cA + hstepA, voffA);
        if (wr == 1) PG8_BAR;
        PG8_WAIT_V(2); PG8_BAR;
        PG8_STAGE(PG8_SB(1, 0), cB + kstep, voffB); PG8_STAGE(PG8_SA(1, 0), cA + kstep, voffA); PG8_STAGE(PG8_SB(1, 1), cB + hstepB + kstep, voffB);
        PG8_WAIT_V(6); PG8_BAR;
    } else {
        PG8_STAGE(PG8_SB(0, 0), cB, voffB); PG8_STAGE(PG8_SA(0, 0), cA, voffA); PG8_STAGE(PG8_SB(0, 1), cB + hstepB, voffB); PG8_STAGE(PG8_SA(0, 1), cA + hstepA, voffA);
        if (wr == 1) PG8_BAR;
        PG8_WAIT_V(4); PG8_BAR;
        PG8_STAGE(PG8_SB(1, 0), cB + kstep, voffB); PG8_STAGE(PG8_SA(1, 0), cA + kstep, voffA); PG8_STAGE(PG8_SB(1, 1), cB + hstepB + kstep, voffB);
        PG8_WAIT_V(6); PG8_BAR;
    }
    for (;;) {
        const bool has_next = S.next(ui + 1, nxt);
        const char* nA = has_next ? (const char*)g.A + (size_t)nxt.pm * tstepA : cA; const char* nB = has_next ? (const char*)g.Bt + (size_t)nxt.pn * tstepB : cB;
        for (int t = 0; t < nt; t += 2) {
            const bool last = (t == nt - 2);
            const char* a1 = cA + (size_t)(t + 1) * kstep;
            const char* a2 = last ? nA : cA + (size_t)(t + 2) * kstep; const char* b2 = last ? nB : cB + (size_t)(t + 2) * kstep;
            const char* a3 = a2 + kstep; const char* b3 = b2 + kstep;
            if (last && has_next) S.a_ready(nxt);
            if constexpr (SP2) {
            PG8_LDB(B0, 0, 0); PG8_LDB(B1, 0, 1); PG8_SCHED; PG8_LDA(At, 0, 0); PG8_STAGE(PG8_SA(1, 1), a1 + hstepA, voffA);
            PG8_WAIT_V(8); PG8_WAIT_L(0); PG8_BAR; PG8_MMA(0, 0, At, B0); PG8_MMA(0, 1, At, B1); PG8_BAR; PG8_SCHED;
            PG8_LDA(At, 0, 1); PG8_STAGE(PG8_SB(0, 0), b2, voffB); PG8_STAGE(PG8_SB(0, 1), b2 + hstepB, voffB); PG8_STAGE(PG8_SA(0, 0), a2, voffA);
            PG8_WAIT_V(8); PG8_WAIT_L(0); PG8_BAR; PG8_MMA(1, 0, At, B0); PG8_MMA(1, 1, At, B1); PG8_BAR; PG8_SCHED;
            PG8_LDB(B0, 1, 0); PG8_LDB(B1, 1, 1); PG8_SCHED; PG8_LDA(At, 1, 0); PG8_STAGE(PG8_SA(0, 1), a2 + hstepA, voffA);
            PG8_WAIT_V(8); PG8_WAIT_L(0); PG8_BAR; PG8_MMA(0, 0, At, B0); PG8_MMA(0, 1, At, B1); PG8_BAR; PG8_SCHED;
            PG8_LDA(At, 1, 1); PG8_STAGE(PG8_SB(1, 0), b3, voffB); PG8_STAGE(PG8_SB(1, 1), b3 + hstepB, voffB); PG8_STAGE(PG8_SA(1, 0), a3, voffA);
            PG8_WAIT_V(8); PG8_WAIT_L(0); PG8_BAR; PG8_MMA(1, 0, At, B0); PG8_MMA(1, 1, At, B1); PG8_BAR; PG8_SCHED;
            } else {
            PG8_LDB(B0, 0, 0); PG8_SCHED; PG8_LDA(At, 0, 0); PG8_STAGE(PG8_SA(1, 1), a1 + hstepA, voffA);
            PG8_WAIT_L(8); PG8_BAR; PG8_WAIT_L(0); PG8_MMA(0, 0, At, B0); PG8_BAR; PG8_SCHED;
            PG8_LDB(B1, 0, 1); PG8_STAGE(PG8_SB(0, 0), b2, voffB);
            PG8_BAR; PG8_WAIT_L(0); PG8_MMA(0, 1, At, B1); PG8_BAR;
            PG8_LDA(At, 0, 1); PG8_STAGE(PG8_SA(0, 0), a2, voffA);
            PG8_BAR; PG8_WAIT_L(0); PG8_MMA(1, 0, At, B0); PG8_BAR; PG8_SCHED;
            PG8_STAGE(PG8_SB(0, 1), b2 + hstepB, voffB);
            PG8_WAIT_V(6); PG8_BAR; PG8_MMA(1, 1, At, B1); PG8_BAR;
            PG8_LDB(B0, 1, 0); PG8_SCHED; PG8_LDA(At, 1, 0); PG8_STAGE(PG8_SA(0, 1), a2 + hstepA, voffA);
            PG8_WAIT_L(8); PG8_BAR; PG8_WAIT_L(0); PG8_MMA(0, 0, At, B0); PG8_BAR; PG8_SCHED;
            PG8_LDB(B1, 1, 1); PG8_STAGE(PG8_SB(1, 0), b3, voffB);
            PG8_BAR; PG8_WAIT_L(0); PG8_MMA(0, 1, At, B1); PG8_BAR;
            PG8_LDA(At, 1, 1); PG8_STAGE(PG8_SA(1, 0), a3, voffA);
            PG8_BAR; PG8_WAIT_L(0); PG8_MMA(1, 0, At, B0); PG8_BAR; PG8_SCHED;
            PG8_STAGE(PG8_SB(1, 1), b3 + hstepB, voffB);
            PG8_WAIT_V(6); PG8_BAR; PG8_MMA(1, 1, At, B1); PG8_BAR;
            }
        }
        if constexpr (ALIGN_EPI) { if (wr == 0) PG8_BAR; }
        if constexpr (!Epi::AFTER_DRAIN) { E(acc, cur, wr, wc, fr, fq); S.done(cur); }
        if (!has_next) break;
#pragma unroll
        for (int a = 0; a < 2; ++a)
#pragma unroll
            for (int b = 0; b < 2; ++b)
#pragma unroll
                for (int m = 0; m < 4; ++m)
#pragma unroll
                    for (int n = 0; n < 2; ++n) acc[a][b][m][n] = (f32x4){0.f, 0.f, 0.f, 0.f};
        cur = nxt; cA = nA; cB = nB; ++ui;
        if constexpr (ALIGN_EPI) { if (wr == 1) PG8_BAR; }
    }
    PG8_WAIT_V(0);
    if constexpr (!ALIGN_EPI) { if (wr == 0) PG8_BAR; }
    PG8_BAR;
    if constexpr (Epi::AFTER_DRAIN) { E.fused(acc, cur, wr, wc, fr, fq, lds, wid, lane); S.done(cur); }
#undef PG8_SA
#undef PG8_SB
#undef PG8_STAGE
#undef PG8_LDA
#undef PG8_LDB
#undef PG8_MMA
#undef PG8_WAIT_V
#undef PG8_WAIT_L
#undef PG8_BAR
#undef PG8_SCHED
}
}

constexpr int DM = 2048, NB = 16, TL = 2048, TCX = 256, DEPTH = 4;
constexpr int ROWS_C = NB * TCX, ROWS_L = NB * TL, M_ALL = ROWS_C + ROWS_L;
constexpr int NMODC = 6 * DM;
constexpr int HG_N = 5 * DM;
constexpr int GDN_N = 12416, GDN_NP = 12544;
constexpr int NA_N = 3 * DM;
constexpr int DFF = 5504, UP_N = 2 * DFF;
constexpr float RMS_EPS = 1e-6f;
constexpr int NWAVES = 8, NTHREADS = 512;

constexpr size_t MiB = (size_t)1 << 20;
constexpr size_t WS_CTL = 0, CTL_ZERO_BYTES = 1 * MiB;
constexpr size_t WS_MOD = 1 * MiB;
constexpr size_t WS_CTXR = 5 * MiB;
constexpr size_t WS_WT_IN = 37 * MiB;
constexpr size_t WS_WT_OUT = 86 * MiB;
constexpr size_t WS_WT_UP = 102 * MiB;
constexpr size_t WS_WT_DN = 145 * MiB;
constexpr size_t WS_P = 167 * MiB;
constexpr size_t WS_O = 1049 * MiB;
constexpr size_t WS_H = 1337 * MiB;
constexpr size_t WS_END = 1481 * MiB;
constexpr int CW_BAR = 4096;

constexpr int LDS_BYTES = 163840;
constexpr int MISC_OFF = LDS_BYTES - 256;

#define GAS __attribute__((address_space(1)))
#define LAS __attribute__((address_space(3)))
typedef unsigned short bf16;
typedef unsigned v4u __attribute__((ext_vector_type(4)));
typedef unsigned v2u __attribute__((ext_vector_type(2)));
typedef float f32x4 __attribute__((ext_vector_type(4)));
typedef GAS const float* gcf;
typedef GAS float* gf;
typedef GAS const bf16* gcb;
typedef GAS bf16* gb;
#define LDS_WAIT() asm volatile("s_waitcnt lgkmcnt(0)" ::: "memory")
#define VM_WAIT() asm volatile("s_waitcnt vmcnt(0)" ::: "memory")
#define LDS_BARRIER() do { asm volatile("s_waitcnt lgkmcnt(0)" ::: "memory"); __builtin_amdgcn_s_barrier(); asm volatile("" ::: "memory"); } while (0)
typedef float f32x2_t __attribute__((ext_vector_type(2)));
typedef __bf16 bf16x2_t __attribute__((ext_vector_type(2)));
__device__ __forceinline__ unsigned pk2(float lo, float hi) { const f32x2_t v = {lo, hi}; return __builtin_bit_cast(unsigned, __builtin_convertvector(v, bf16x2_t)); }
__device__ __forceinline__ unsigned f2bf(float f) { return pk2(f, 0.f) & 0xffffu; }
__device__ __forceinline__ float bflo(unsigned u) { return __builtin_bit_cast(float, u << 16); }
__device__ __forceinline__ float bfhi(unsigned u) { return __builtin_bit_cast(float, u & 0xffff0000u); }
__device__ __forceinline__ float bf2f(bf16 b) { return __builtin_bit_cast(float, (unsigned)b << 16); }
__device__ __forceinline__ float silu_f(float x) { return x * __builtin_amdgcn_rcpf(1.f + __expf(-x)); }
__device__ __forceinline__ float sigmoid_f(float x) { return __builtin_amdgcn_rcpf(1.f + __expf(-x)); }
template <int CTRL> __device__ __forceinline__ float dppf(float x) { return __builtin_bit_cast(float, __builtin_amdgcn_mov_dpp(__builtin_bit_cast(int, x), CTRL, 0xf, 0xf, true)); }
__device__ __forceinline__ float sum8(float x) { x += dppf<0xB1>(x); x += dppf<0x4E>(x); x += dppf<0x141>(x); return x; }
__device__ __forceinline__ float max8(float x) { x = fmaxf(x, dppf<0xB1>(x)); x = fmaxf(x, dppf<0x4E>(x)); x = fmaxf(x, dppf<0x141>(x)); return x; }
__device__ __forceinline__ float sum16(float x) { x = sum8(x); x += dppf<0x128>(x); return x; }
__device__ __forceinline__ float sum32(float x) { x = sum16(x); auto s = __builtin_amdgcn_permlane16_swap(__float_as_uint(x), __float_as_uint(x), false, false); return __uint_as_float(s[0]) + __uint_as_float(s[1]); }
__device__ __forceinline__ float wave_sum(float x) { x = sum32(x); auto t = __builtin_amdgcn_permlane32_swap(__float_as_uint(x), __float_as_uint(x), false, false); return __uint_as_float(t[0]) + __uint_as_float(t[1]); }

#define XB_TMO      128
#define XB_XCNT(j)  (256  + 64 * (j))
#define XB_XSUB(j)  (1280 + 64 * (j))
#define XB_XGEN(j)  (2304 + 64 * (j))
#define XB_TOP      3328
#define XB_TOPGEN   3392
#define XCD_BAR_WORDS 3456
#define XB_SPIN_CAP (1u << 18)
__device__ __forceinline__ unsigned xb_ld(unsigned* p)              { return __hip_atomic_load(p, __ATOMIC_RELAXED, __HIP_MEMORY_SCOPE_AGENT); }
__device__ __forceinline__ unsigned xb_add(unsigned* p, unsigned v) { return __hip_atomic_fetch_add(p, v, __ATOMIC_RELAXED, __HIP_MEMORY_SCOPE_AGENT); }
__device__ __forceinline__ unsigned xb_xcc_id() { return (unsigned)__builtin_amdgcn_s_getreg((3 << 11) | 20) & 0xFu; }
#define XB_SPIN(cond, bar) do { unsigned _sp = 0; while (cond) { __builtin_amdgcn_s_sleep(1); \
    if ((++_sp & 255u) == 0u) { if (xb_ld(&(bar)[XB_TMO])) break; if (_sp > XB_SPIN_CAP) { atomicAdd(&(bar)[XB_TMO], 1u); break; } } } } while (0)
struct XcdBarrier { unsigned* bar; unsigned x; volatile LAS unsigned* st; };
__device__ __forceinline__ XcdBarrier xcd_barrier_post(unsigned* bar, volatile LAS unsigned* st, const int tid) {
    XcdBarrier b; b.bar = bar; b.x = xb_xcc_id(); b.st = st;
    if (tid == 0) (void)xb_add(&bar[XB_XCNT(b.x)], 1u);
    return b;
}
__device__ __forceinline__ void xcd_barrier_complete(unsigned* bar, unsigned x, unsigned& nloc, unsigned& nx) {
    const unsigned G = gridDim.x * gridDim.y * gridDim.z;
    unsigned sum, cnt, mine, sp = 0u;
    for (;;) {
        sum = 0u; cnt = 0u; mine = 0u;
#pragma unroll
        for (unsigned j = 0; j < 16; ++j) { const unsigned c = xb_ld(&bar[XB_XCNT(j)]); sum += c; cnt += (c > 0u) ? 1u : 0u; mine = (j == x) ? c : mine; }
        if (sum == G) break;
        __builtin_amdgcn_s_sleep(1);
        if ((++sp & 255u) == 0u) { if (xb_ld(&bar[XB_TMO])) break; if (sp > XB_SPIN_CAP) { atomicAdd(&bar[XB_TMO], 1u); break; } }
    }
    nloc = mine > 0u ? mine : 1u; nx = cnt > 0u ? cnt : 1u;
}
__device__ __forceinline__ void xcd_barrier(const XcdBarrier& b, const int tid) {
    asm volatile("s_waitcnt vmcnt(0)" ::: "memory");
    __syncthreads();
    if (tid == 0) {
        unsigned* bar = b.bar;
        __builtin_amdgcn_s_waitcnt(0);
        unsigned nloc = b.st[0], nx = b.st[1];
        if (nloc == 0u) { xcd_barrier_complete(bar, b.x, nloc, nx); b.st[0] = nloc; b.st[1] = nx; }
        const unsigned old = xb_add(&bar[XB_XSUB(b.x)], 1u);
        const unsigned gen = old / nloc;
        if (old + 1u == (gen + 1u) * nloc) {
            __builtin_amdgcn_fence(__ATOMIC_RELEASE, "agent");
            asm volatile("s_waitcnt vmcnt(0)" ::: "memory");
            const unsigned og = xb_add(&bar[XB_TOP], 1u);
            const unsigned tg = og / nx;
            if (og + 1u == (tg + 1u) * nx) xb_add(&bar[XB_TOPGEN], 1u);
            else XB_SPIN(xb_ld(&bar[XB_TOPGEN]) == tg, bar);
            __builtin_amdgcn_fence(__ATOMIC_ACQUIRE, "agent");
            xb_add(&bar[XB_XGEN(b.x)], 1u);
            asm volatile("s_waitcnt vmcnt(0)" ::: "memory");
        } else {
            XB_SPIN(xb_ld(&bar[XB_XGEN(b.x)]) == gen, bar);
            __builtin_amdgcn_fence(__ATOMIC_ACQUIRE, "agent");
            asm volatile("s_waitcnt vmcnt(0)" ::: "memory");
        }
    }
    __syncthreads();
}

struct Args { const float* in[26]; float* out; unsigned char* ws; int ph_lo, ph_hi; };
enum { I_X = 0, I_C, I_CTX, I_CCTX, I_ADAW, I_ADAB, I_NMG, I_NFG, I_HGWIN, I_HGLB, I_HGNG, I_HGWOUT, I_GDNWIN, I_GDNCW, I_GDNALOG, I_GDNDTB, I_GDNNG, I_GDNWOUT,
       I_NAWQKV, I_NAQG, I_NAKG, I_NARPB, I_NAWOUT, I_FFNUP, I_FFNCW, I_FFNDN };
#define FRAME_TID(F) do { (F).lane = pg8::lane_id_asm(); (F).tid = (F).wave * 64 + (F).lane; } while (0)
struct Frame {
    LAS unsigned char* lds;
    int tid, lane, wave, G, gw, NGW;
    gcf in[26];
    gf out;
    GAS unsigned char* ws;
};

__device__ __forceinline__ void transpose_item(gcf W, int K, int N, gb WT, LAS float* scr, int item, int lane, bool perm_up = false) {
    const int nblk = N / 32, kb = item / nblk, nb = item % nblk, k0 = 64 * kb, n0 = 32 * nb;
    int nr0 = n0; if (perm_up) { const int half = n0 / DFF, jx = n0 - half * DFF; nr0 = (jx >> 7) * 256 + half * 128 + (jx & 127); }
    float wv[32];
#pragma unroll
    for (int i = 0; i < 32; ++i) { const int kk = 2 * i + (lane >> 5); wv[i] = W[(size_t)(k0 + kk) * N + n0 + (lane & 31)]; }
#pragma unroll
    for (int i = 0; i < 32; ++i) { const int kk = 2 * i + (lane >> 5); scr[kk * 33 + (lane & 31)] = wv[i]; }
    LDS_WAIT(); asm volatile("" ::: "memory");
    const int c = lane & 7;
#pragma unroll
    for (int j = 0; j < 4; ++j) { const int n = (lane >> 3) + 8 * j; const LAS float* s = scr + (8 * c) * 33 + n;
        v4u o; o.x = pk2(s[0 * 33], s[1 * 33]); o.y = pk2(s[2 * 33], s[3 * 33]); o.z = pk2(s[4 * 33], s[5 * 33]); o.w = pk2(s[6 * 33], s[7 * 33]);
        *(GAS v4u*)(WT + (size_t)(nr0 + n) * K + k0 + 8 * c) = o; }
    LDS_WAIT(); asm volatile("" ::: "memory");
}

__device__ __forceinline__ void phase_mod(Frame& F) {
    FRAME_TID(F);
    LAS float* red = (LAS float*)F.lds;
    gf mod = (gf)(F.ws + WS_MOD);
    const int w = F.wave;
    for (int item = blockIdx.x; item < (4 * NMODC) / 192; item += F.G) {
        int lane = F.lane; asm volatile("" : "+v"(lane));
        const int j = lane & 15, kq = lane >> 4;
        const int col0 = item * 192, i = col0 / NMODC, n0 = col0 - i * NMODC;
        gcf wp = F.in[I_ADAW] + ((size_t)i * 2048 + w * 256 + 4 * kq) * NMODC + n0 + 4 * j;
        gcf cp = F.in[I_C] + j * 2048 + w * 256 + 4 * kq;
        gcf xp = F.in[I_CCTX] + w * 256 + 4 * kq;
        f32x4 acc[3][4], a16[3];
#pragma unroll
        for (int g = 0; g < 3; ++g) { a16[g] = (f32x4){0.f, 0.f, 0.f, 0.f};
#pragma unroll
            for (int t = 0; t < 4; ++t) acc[g][t] = (f32x4){0.f, 0.f, 0.f, 0.f}; }
#pragma unroll 2
        for (int kk = 0; kk < 16; ++kk) {
            const f32x4 cv = *(const GAS f32x4*)(cp + kk * 16), xv = *(const GAS f32x4*)(xp + kk * 16);
            f32x4 sa, sx;
#pragma unroll
            for (int e = 0; e < 4; ++e) { sa[e] = silu_f(cv[e]); sx[e] = silu_f(xv[e]); }
#pragma unroll
            for (int e = 0; e < 4; ++e)
#pragma unroll
                for (int g = 0; g < 3; ++g) {
                    const f32x4 wv = *(const GAS f32x4*)(wp + (size_t)(kk * 16 + e) * NMODC + g * 64);
#pragma unroll
                    for (int t = 0; t < 4; ++t) acc[g][t] = __builtin_amdgcn_mfma_f32_16x16x4f32(sa[e], wv[t], acc[g][t], 0, 0, 0);
                    a16[g] = a16[g] + wv * sx[e];
                }
        }
#pragma unroll
        for (int g = 0; g < 3; ++g) {
#pragma unroll
            for (int r = 0; r < 4; ++r) *(LAS f32x4*)(red + (w * 17 + 4 * kq + r) * 192 + 64 * g + 4 * j) = (f32x4){acc[g][0][r], acc[g][1][r], acc[g][2][r], acc[g][3][r]};
            f32x4 s = a16[g];
#pragma unroll
            for (int t = 0; t < 4; ++t) { float x = s[t];
                { auto p = __builtin_amdgcn_permlane16_swap(__float_as_uint(x), __float_as_uint(x), false, false); x = __uint_as_float(p[0]) + __uint_as_float(p[1]); }
                { auto p = __builtin_amdgcn_permlane32_swap(__float_as_uint(x), __float_as_uint(x), false, false); x = __uint_as_float(p[0]) + __uint_as_float(p[1]); }
                s[t] = x; }
            if (kq == 0) *(LAS f32x4*)(red + (w * 17 + 16) * 192 + 64 * g + 4 * j) = s;
        }
        __syncthreads();
        for (int idx = F.tid; idx < 17 * 192; idx += NTHREADS) { const int r = idx / 192, c = idx - r * 192;
            float v = F.in[I_ADAB][i * NMODC + n0 + c];
#pragma unroll
            for (int ww = 0; ww < 8; ++ww) v += red[(ww * 17 + r) * 192 + c];
            mod[((size_t)i * 17 + r) * NMODC + n0 + c] = v; }
        __syncthreads();
    }
}

__device__ __forceinline__ void phase_wprep(Frame& F, int L) {
    FRAME_TID(F);
    const int m = L % 3, j = L / 3;
    LAS float* scr = (LAS float*)(F.lds + F.wave * 16384);
    gcf Win = (m == 0) ? F.in[I_HGWIN] + (size_t)j * DM * HG_N : (m == 1) ? F.in[I_GDNWIN] : F.in[I_NAWQKV];
    const int Nin = (m == 0) ? HG_N : (m == 1) ? GDN_N : NA_N;
    gcf Wout = (m == 0) ? F.in[I_HGWOUT] + (size_t)j * DM * DM : (m == 1) ? F.in[I_GDNWOUT] : F.in[I_NAWOUT];
    const int Kout = (m == 1) ? 2 * DM : DM;
    gcf Wup = F.in[I_FFNUP] + (size_t)L * DM * UP_N;
    gcf Wdn = F.in[I_FFNDN] + (size_t)L * DFF * DM;
    gb Tin = (gb)(F.ws + WS_WT_IN), Tout = (gb)(F.ws + WS_WT_OUT), Tup = (gb)(F.ws + WS_WT_UP), Tdn = (gb)(F.ws + WS_WT_DN);
    const int I_in = (DM / 64) * (Nin / 32), I_out = (Kout / 64) * (DM / 32), I_up = (DM / 64) * (UP_N / 32), I_dn = (DFF / 64) * (DM / 32);
    const int total = I_in + I_out + I_up + I_dn;
    for (int it = F.gw; it < total; it += F.NGW) {
        int r = it;
        if (r < I_in) { transpose_item(Win, DM, Nin, Tin, scr, r, F.lane); continue; } r -= I_in;
        if (r < I_out) { transpose_item(Wout, Kout, DM, Tout, scr, r, F.lane); continue; } r -= I_out;
        if (r < I_up) { transpose_item(Wup, DM, UP_N, Tup, scr, r, F.lane, true); continue; } r -= I_up;
        transpose_item(Wdn, DFF, DM, Tdn, scr, r, F.lane);
    }
    if (m == 1) {
        GAS v4u* z = (GAS v4u*)(Tin + (size_t)GDN_N * DM);
        const int n16 = (GDN_NP - GDN_N) * DM * 2 / 16;
        for (int i = blockIdx.x * NTHREADS + F.tid; i < n16; i += F.G * NTHREADS) z[i] = (v4u){0u, 0u, 0u, 0u};
    }
}

template <bool IN16> __device__ __forceinline__ void phase_norm(Frame& F, gcf gvec, gcf modL, int chunk, gcf xlat, gcf xctx, GAS const _Float16* x16, int row_lo, int row_hi) {
    FRAME_TID(F);
    gb H = (gb)(F.ws + WS_H);
    const int nrows = row_hi - row_lo, rpw = (nrows + F.NGW - 1) / F.NGW;
    const int r0 = row_lo + F.gw * rpw, r1 = (r0 + rpw < row_hi) ? r0 + rpw : row_hi;
    int cur = -1; f32x4 Av[8], Bv[8];
    for (int r = r0; r < r1; ++r) {
        const int mr = (r < ROWS_C) ? 16 : ((r - ROWS_C) >> 11);
        if (mr != cur) { cur = mr;
#pragma unroll
            for (int jj = 0; jj < 8; ++jj) { const int c = (F.lane + 64 * jj) * 4;
                const f32x4 g4 = *(GAS const f32x4*)(gvec + c), sc = *(GAS const f32x4*)(modL + (size_t)mr * NMODC + (chunk + 1) * DM + c), sh = *(GAS const f32x4*)(modL + (size_t)mr * NMODC + chunk * DM + c);
                Av[jj] = g4 * (sc + 1.0f); Bv[jj] = sh; } }
        f32x4 v[8]; float ss = 0.f;
        if constexpr (IN16) {
            typedef _Float16 h4_t __attribute__((ext_vector_type(4)));
            GAS const _Float16* xr = x16 + (size_t)r * DM;
            h4_t hv[8];
#pragma unroll
            for (int jj = 0; jj < 8; ++jj) hv[jj] = *(GAS const h4_t*)(xr + (F.lane + 64 * jj) * 4);
#pragma unroll
            for (int jj = 0; jj < 8; ++jj) v[jj] = __builtin_convertvector(hv[jj], f32x4);
        } else {
            gcf xr = (r < ROWS_C) ? xctx + (size_t)r * DM : xlat + (size_t)(r - ROWS_C) * DM;
#pragma unroll
            for (int jj = 0; jj < 8; ++jj) v[jj] = *(GAS const f32x4*)(xr + (F.lane + 64 * jj) * 4);
        }
#pragma unroll
        for (int jj = 0; jj < 8; ++jj) ss += (v[jj].x * v[jj].x + v[jj].y * v[jj].y) + (v[jj].z * v[jj].z + v[jj].w * v[jj].w);
        const float rstd = __builtin_amdgcn_rsqf(wave_sum(ss) * (1.f / DM) + RMS_EPS);
        GAS v2u* o = (GAS v2u*)(H + (size_t)r * DM);
#pragma unroll
        for (int jj = 0; jj < 8; ++jj) { const f32x4 y = v[jj] * rstd * Av[jj] + Bv[jj]; o[F.lane + 64 * jj] = (v2u){pk2(y.x, y.y), pk2(y.z, y.w)}; }
    }
}

__device__ __forceinline__ void phase_ffnfix(Frame& F, int L, int row_lo, int row_hi) {
    FRAME_TID(F);
    gcb SIDE = (gcb)(F.ws + WS_WT_IN); gb Gt = (gb)(F.ws + WS_P);   gcf cw = F.in[I_FFNCW] + (size_t)L * 3 * UP_N;
    const int s_lo = row_lo / 64, s_hi = row_hi / 64;
    const int nitems = (s_hi - s_lo) * 2 * (DFF / 8);
    for (int it = blockIdx.x * NTHREADS + F.tid; it < nitems; it += F.G * NTHREADS) {
        const int cg = it % (DFF / 8), rs = it / (DFF / 8), s = s_lo + (rs >> 1), last = rs & 1;
        const int row = s * 64 + (last ? 63 : 0);
        const int sl = (row < ROWS_C) ? (row & 255) : ((row - ROWS_C) & 2047), slen = (row < ROWS_C) ? TCX : TL;
        const int jg = cg * 8, np = (jg >> 7) * 256 + (jg & 127);
        gcb pprev = last ? (SIDE + ((size_t)s * 4 + 2) * UP_N) : (SIDE + ((size_t)(s - 1) * 4 + 3) * UP_N);
        gcb pcur = SIDE + ((size_t)s * 4 + (last ? 3 : 0)) * UP_N;
        gcb pnext = last ? (SIDE + ((size_t)(s + 1) * 4 + 0) * UP_N) : (SIDE + ((size_t)s * 4 + 1) * UP_N);
        const bool has_prev = last || sl > 0, has_next = !last || (sl + 1) < slen;
        const v4u z4 = (v4u){0u, 0u, 0u, 0u};
        const v4u pa = has_prev ? *(GAS const v4u*)(pprev + np) : z4, pb = has_prev ? *(GAS const v4u*)(pprev + np + 128) : z4;
        const v4u ca = *(GAS const v4u*)(pcur + np), cb = *(GAS const v4u*)(pcur + np + 128);
        const v4u na = has_next ? *(GAS const v4u*)(pnext + np) : z4, nb = has_next ? *(GAS const v4u*)(pnext + np + 128) : z4;
        float wta[3][8], wtb[3][8];
#pragma unroll
        for (int t = 0; t < 3; ++t) { const f32x4 a0 = *(GAS const f32x4*)(cw + t * UP_N + jg), a1 = *(GAS const f32x4*)(cw + t * UP_N + jg + 4), b0 = *(GAS const f32x4*)(cw + t * UP_N + DFF + jg), b1 = *(GAS const f32x4*)(cw + t * UP_N + DFF + jg + 4);
            wta[t][0] = a0.x; wta[t][1] = a0.y; wta[t][2] = a0.z; wta[t][3] = a0.w; wta[t][4] = a1.x; wta[t][5] = a1.y; wta[t][6] = a1.z; wta[t][7] = a1.w;
            wtb[t][0] = b0.x; wtb[t][1] = b0.y; wtb[t][2] = b0.z; wtb[t][3] = b0.w; wtb[t][4] = b1.x; wtb[t][5] = b1.y; wtb[t][6] = b1.z; wtb[t][7] = b1.w; }
        float g[8];
#pragma unroll
        for (int e = 0; e < 8; ++e) {
            const unsigned wpa = (e < 2) ? pa.x : (e < 4) ? pa.y : (e < 6) ? pa.z : pa.w, wca = (e < 2) ? ca.x : (e < 4) ? ca.y : (e < 6) ? ca.z : ca.w, wna = (e < 2) ? na.x : (e < 4) ? na.y : (e < 6) ? na.z : na.w;
            const unsigned wpb = (e < 2) ? pb.x : (e < 4) ? pb.y : (e < 6) ? pb.z : pb.w, wcb = (e < 2) ? cb.x : (e < 4) ? cb.y : (e < 6) ? cb.z : cb.w, wnb = (e < 2) ? nb.x : (e < 4) ? nb.y : (e < 6) ? nb.z : nb.w;
            const float ap = (e & 1) ? bfhi(wpa) : bflo(wpa), ac = (e & 1) ? bfhi(wca) : bflo(wca), an = (e & 1) ? bfhi(wna) : bflo(wna);
            const float bp = (e & 1) ? bfhi(wpb) : bflo(wpb), bc = (e & 1) ? bfhi(wcb) : bflo(wcb), bn = (e & 1) ? bfhi(wnb) : bflo(wnb);
            const float a = ap * wta[0][e] + ac * wta[1][e] + an * wta[2][e];
            const float b = bp * wtb[0][e] + bc * wtb[1][e] + bn * wtb[2][e];
            g[e] = silu_f(a) * b;
        }
        *(GAS v4u*)(Gt + (size_t)row * DFF + jg) = (v4u){pk2(g[0], g[1]), pk2(g[2], g[3]), pk2(g[4], g[5]), pk2(g[6], g[7])};
    }
}

typedef short hb8 __attribute__((ext_vector_type(8)));
typedef short hb4 __attribute__((ext_vector_type(4)));
typedef float v2f __attribute__((ext_vector_type(2)));
#define MFMA16(a, b, c) __builtin_amdgcn_mfma_f32_16x16x32_bf16((a), (b), (c), 0, 0, 0)
constexpr int HQS = 144, HTS = 80, HOS = 132;
constexpr int HG_QT = 0, HG_KT = 18432, HG_KTT = 36864, HG_VT = 57344, HG_ATT = 77824, HG_SB = 88064, HG_ER = 124928, HG_EEND = 125440, HG_SEG = 125952;
__device__ __forceinline__ int hg_row(int b, int d, int pos) {
    return (pos < TCX) ? (b * TCX + (d ? (TCX - 1 - pos) : pos)) : (ROWS_C + b * TL + (d ? (TL - 1 - (pos - TCX)) : (pos - TCX)));
}
__device__ __forceinline__ void phase_hg2(Frame& F, int j, bool ctx_out, bool dry = false) {
    FRAME_TID(F);
    gb P = (gb)(F.ws + WS_P); gb OF = (gb)(F.ws + WS_O);
    gcf lbl = F.in[I_HGLB]; gcf ng = F.in[I_HGNG] + j * 128;
    LAS bf16* Qt = (LAS bf16*)(F.lds + HG_QT); LAS bf16* Kt = (LAS bf16*)(F.lds + HG_KT); LAS bf16* KtT = (LAS bf16*)(F.lds + HG_KTT); LAS bf16* VT = (LAS bf16*)(F.lds + HG_VT);
    LAS bf16* ATT = (LAS bf16*)(F.lds + HG_ATT); LAS bf16* SB = (LAS bf16*)(F.lds + HG_SB);
    LAS float* er = (LAS float*)(F.lds + HG_ER); LAS float* eend = (LAS float*)(F.lds + HG_EEND); LAS float* segs = (LAS float*)(F.lds + HG_SEG);
    LAS float* s_ng = (LAS float*)(F.lds + 131072);
    LAS float* O32 = (LAS float*)(F.lds + HG_QT);
    const int c2_ = F.tid & 63, seg_ = F.tid >> 6;
    const int l15_ = F.lane & 15, q4_ = F.lane >> 4, vb = F.wave;
    const int rt = F.tid >> 3, g8 = F.tid & 7;
    for (int item = blockIdx.x; item < NB * 16; item += F.G) {
        const int b = item >> 4, h = item & 15;
        if (F.tid < 128) s_ng[F.tid] = ng[F.tid];
        for (int d = 0; d < 2; ++d) {
            float lb0, lb1;
            { const int cc = 2 * c2_;
              const float a0 = lbl[(0 * 2 + d) * DM + h * 128 + cc], a1 = lbl[(1 * 2 + d) * DM + h * 128 + cc], b0 = lbl[(0 * 2 + d) * DM + h * 128 + cc + 1], b1 = lbl[(1 * 2 + d) * DM + h * 128 + cc + 1];
              const float mx = fmaxf(a0, a1), e0 = __expf(a0 - mx), e1 = __expf(a1 - mx), my = fmaxf(b0, b1), f0 = __expf(b0 - my), f1 = __expf(b1 - my);
              lb0 = (j == 0) ? 0.f : e1 / (e0 + e1); lb1 = (j == 0) ? 0.f : f1 / (f0 + f1); }
            f32x4 S[8];
#pragma unroll
            for (int kt = 0; kt < 8; ++kt) S[kt] = (f32x4){0.f, 0.f, 0.f, 0.f};
            unsigned rq[8], rf[8], rv[8];
            {
                gcb pr = P + h * 128 + 2 * c2_;
#pragma unroll
                for (int i = 0; i < 8; ++i) { const size_t ro = (size_t)hg_row(b, d, seg_ * 8 + i) * HG_N; rq[i] = *(GAS const unsigned*)(pr + ro); rv[i] = *(GAS const unsigned*)(pr + ro + DM); rf[i] = *(GAS const unsigned*)(pr + ro + (2 + d) * DM); }
            }
#pragma unroll 1
            for (int ch = 0; ch < (TCX + TL) / 64; ++ch) {
                const int s0 = ch * 64;
                int c2 = c2_, l15 = l15_, q4 = q4_; asm volatile("" : "+v"(c2), "+v"(l15), "+v"(q4)); const int seg = vb;
                LDS_BARRIER();
                unsigned kp[8]; float pr0[8], pr1[8]; float tot0 = 1.f, tot1 = 1.f;
                {
                    float f0[8], f1[8];
#pragma unroll
                    for (int i = 0; i < 8; ++i) {
                        const float xf0 = bflo(rf[i]), xf1 = bfhi(rf[i]);
                        const float ex0 = __expf(-fabsf(xf0)), rc0 = __builtin_amdgcn_rcpf(1.f + ex0), ex1 = __expf(-fabsf(xf1)), rc1 = __builtin_amdgcn_rcpf(1.f + ex1);
                        const float sp0 = (xf0 >= 0.f) ? rc0 : ex0 * rc0, sn0 = (xf0 >= 0.f) ? ex0 * rc0 : rc0, sp1 = (xf1 >= 0.f) ? rc1 : ex1 * rc1, sn1 = (xf1 >= 0.f) ? ex1 * rc1 : rc1;
                        kp[i] = pk2((1.f - lb0) * sn0, (1.f - lb1) * sn1);
                        f0[i] = fmaxf(lb0 + (1.f - lb0) * sp0, 1e-30f); f1[i] = fmaxf(lb1 + (1.f - lb1) * sp1, 1e-30f);
                    }
                    if (seg >= 4) {
#pragma unroll
                        for (int i = 0; i < 8; ++i) { tot0 = fmaxf(tot0 * f0[i], 1e-30f); tot1 = fmaxf(tot1 * f1[i], 1e-30f); pr0[i] = tot0; pr1[i] = tot1; }
                    } else {
#pragma unroll
                        for (int i = 7; i >= 0; --i) { pr0[i] = tot0; pr1[i] = tot1; tot0 = fmaxf(tot0 * f0[i], 1e-30f); tot1 = fmaxf(tot1 * f1[i], 1e-30f); }
                    }
                }
                *(LAS v2f*)(segs + seg * 128 + 2 * c2) = (v2f){tot0, tot1};
                {
                    const v4u w0 = (v4u){(rv[0] & 0xffffu) | (rv[1] << 16), (rv[2] & 0xffffu) | (rv[3] << 16), (rv[4] & 0xffffu) | (rv[5] << 16), (rv[6] & 0xffffu) | (rv[7] << 16)};
                    const v4u w1 = (v4u){(rv[0] >> 16) | (rv[1] & 0xffff0000u), (rv[2] >> 16) | (rv[3] & 0xffff0000u), (rv[4] >> 16) | (rv[5] & 0xffff0000u), (rv[6] >> 16) | (rv[7] & 0xffff0000u)};
                    *(LAS v4u*)(VT + (2 * c2) * HTS + seg * 8) = w0; *(LAS v4u*)(VT + (2 * c2 + 1) * HTS + seg * 8) = w1;
                }
                unsigned qp[8];
#pragma unroll
                for (int i = 0; i < 8; ++i) qp[i] = rq[i];
                int rto = rt, g8o = g8; asm volatile("" : "+v"(rto), "+v"(g8o));
                const int rrow = hg_row(b, d, s0 + rto);
                const bool do_out = (d == 1) && !dry && (ctx_out || s0 >= TCX);
                v4u pf[2], pg[2];
                { const int lrow = do_out ? rrow : 0;
                    const unsigned fo = ((unsigned)lrow * DM + g8o * 16) * 2u, go = ((unsigned)lrow * HG_N + g8o * 16) * 2u;
                    GAS const char* ofb = (GAS const char*)(OF + h * 128); GAS const char* gb_ = (GAS const char*)(P + 4 * DM + h * 128);
                    pf[0] = *(GAS const v4u*)(ofb + fo); pf[1] = *(GAS const v4u*)(ofb + fo + 16); pg[0] = *(GAS const v4u*)(gb_ + go); pg[1] = *(GAS const v4u*)(gb_ + go + 16); }
                {
                    const int s0n = (ch + 1 < (TCX + TL) / 64) ? s0 + 64 : s0;
                    GAS const char* ub = (GAS const char*)(P + h * 128 + (size_t)hg_row(b, d, s0n + seg * 8) * HG_N);
                    const long stpb = d ? -(long)HG_N * 2 : (long)HG_N * 2;
                    const unsigned vo = 4u * (unsigned)c2;
                    const unsigned vo1 = vo + DM * 2, vo2 = vo + (2 + d) * DM * 2;
#pragma unroll
                    for (int i = 0; i < 8; ++i) { GAS const char* ui = ub + i * stpb; rq[i] = *(GAS const unsigned*)(ui + vo); rv[i] = *(GAS const unsigned*)(ui + vo1); rf[i] = *(GAS const unsigned*)(ui + vo2); }
                }
                LDS_BARRIER();
                float m0 = 1.f, m1 = 1.f, er0 = 1.f, er1 = 1.f, en0 = 1.f, en1 = 1.f;
#pragma unroll
                for (int sg = 0; sg < 8; ++sg) { const v2f g = *(const LAS v2f*)(segs + sg * 128 + 2 * c2);
                    if (sg < 4) { er0 = fmaxf(er0 * g.x, 1e-30f); er1 = fmaxf(er1 * g.y, 1e-30f); } else { en0 = fmaxf(en0 * g.x, 1e-30f); en1 = fmaxf(en1 * g.y, 1e-30f); }
                    const bool inm = (seg >= 4) ? (sg >= 4 && sg < seg) : (sg > seg && sg < 4);
                    if (inm) { m0 = fmaxf(m0 * g.x, 1e-30f); m1 = fmaxf(m1 * g.y, 1e-30f); } }
                if (seg == 0) { *(LAS v2f*)(er + 2 * c2) = (v2f){er0, er1}; *(LAS v2f*)(eend + 2 * c2) = (v2f){en0, en1}; }
                {
                    unsigned k0[8], k1[8];
#pragma unroll
                    for (int i = 0; i < 8; ++i) { const int t = seg * 8 + i;
                        const float small0 = fmaxf(m0 * pr0[i], 1e-30f), small1 = fmaxf(m1 * pr1[i], 1e-30f);
                        const float big0 = __builtin_amdgcn_rcpf(small0), big1 = __builtin_amdgcn_rcpf(small1);
                        const float eq0 = (seg >= 4) ? small0 : big0, eq1 = (seg >= 4) ? small1 : big1, ek0 = (seg >= 4) ? big0 : small0, ek1 = (seg >= 4) ? big1 : small1;
                        *(LAS unsigned*)(Qt + t * HQS + 2 * c2) = pk2(bflo(qp[i]) * eq0, bfhi(qp[i]) * eq1);
                        const unsigned kk2 = pk2(bflo(kp[i]) * ek0, bfhi(kp[i]) * ek1);
                        k0[i] = kk2 & 0xffffu; k1[i] = kk2 >> 16;
                        *(LAS unsigned*)(Kt + t * HQS + 2 * c2) = kk2; }
                    *(LAS v4u*)(KtT + (2 * c2) * HTS + seg * 8) = (v4u){k0[0] | (k0[1] << 16), k0[2] | (k0[3] << 16), k0[4] | (k0[5] << 16), k0[6] | (k0[7] << 16)};
                    *(LAS v4u*)(KtT + (2 * c2 + 1) * HTS + seg * 8) = (v4u){k1[0] | (k1[1] << 16), k1[2] | (k1[3] << 16), k1[4] | (k1[5] << 16), k1[6] | (k1[7] << 16)};
                }
                LDS_BARRIER();
#pragma unroll
                for (int kt = 0; kt < 8; ++kt) { const f32x4 e4 = *(const LAS f32x4*)(er + kt * 16 + q4 * 4); S[kt] = S[kt] * e4; }
#pragma unroll
                for (int tl = 0; tl < 2; ++tl) { const int id = F.wave * 2 + tl, st = id >> 2, tt = id & 3;
                    f32x4 a = (f32x4){0.f, 0.f, 0.f, 0.f};
                    if (tt >= st) {
#pragma unroll
                        for (int ks = 0; ks < 4; ++ks) { const hb8 fa = *(const LAS hb8*)(Kt + (st * 16 + l15) * HQS + ks * 32 + q4 * 8), fb = *(const LAS hb8*)(Qt + (tt * 16 + l15) * HQS + ks * 32 + q4 * 8);
                            a = MFMA16(fa, fb, a); }
                    }
                    const int tg = tt * 16 + l15, sg = st * 16 + q4 * 4;
                    const float a0 = (sg + 0 <= tg) ? a.x : 0.f, a1 = (sg + 1 <= tg) ? a.y : 0.f, a2 = (sg + 2 <= tg) ? a.z : 0.f, a3 = (sg + 3 <= tg) ? a.w : 0.f;
                    *(LAS v2u*)(ATT + tg * HTS + sg) = (v2u){pk2(a0, a1), pk2(a2, a3)}; }
                f32x4 Oa[4];
#pragma unroll
                for (int tt = 0; tt < 4; ++tt) Oa[tt] = (f32x4){0.f, 0.f, 0.f, 0.f};
#pragma unroll
                for (int ks = 0; ks < 4; ++ks) {
                    const v4u sb4 = (v4u){pk2(S[2 * ks].x, S[2 * ks].y), pk2(S[2 * ks].z, S[2 * ks].w), pk2(S[2 * ks + 1].x, S[2 * ks + 1].y), pk2(S[2 * ks + 1].z, S[2 * ks + 1].w)};
                    const hb8 fb = __builtin_bit_cast(hb8, sb4);
#pragma unroll
                    for (int tt = 0; tt < 4; ++tt) { const v2u a0 = *(const LAS v2u*)(Qt + (tt * 16 + l15) * HQS + ks * 32 + q4 * 4), a1 = *(const LAS v2u*)(Qt + (tt * 16 + l15) * HQS + ks * 32 + 16 + q4 * 4);
                        const v4u fa4 = (v4u){a0.x, a0.y, a1.x, a1.y}; Oa[tt] = MFMA16(__builtin_bit_cast(hb8, fa4), fb, Oa[tt]); } }
                LDS_BARRIER();
#pragma unroll
                for (int ss = 0; ss < 2; ++ss) { const hb8 fb = *(const LAS hb8*)(VT + (vb * 16 + l15) * HTS + ss * 32 + q4 * 8);
#pragma unroll
                    for (int tt = 0; tt < 4; ++tt) { const hb8 fa = *(const LAS hb8*)(ATT + (tt * 16 + l15) * HTS + ss * 32 + q4 * 8); Oa[tt] = MFMA16(fa, fb, Oa[tt]); }
#pragma unroll
                    for (int kt = 0; kt < 8; ++kt) { const hb8 fa = *(const LAS hb8*)(KtT + (kt * 16 + l15) * HTS + ss * 32 + q4 * 8); S[kt] = MFMA16(fa, fb, S[kt]); } }
#pragma unroll
                for (int kt = 0; kt < 8; ++kt) { const f32x4 e4 = *(const LAS f32x4*)(eend + kt * 16 + q4 * 4); S[kt] = S[kt] * e4; }
#pragma unroll
                for (int tt = 0; tt < 4; ++tt) {
#pragma unroll
                    for (int i = 0; i < 4; ++i) O32[(tt * 16 + q4 * 4 + i) * HOS + vb * 16 + l15] = Oa[tt][i]; }
                LDS_BARRIER();
                {
                    f32x4 o[4];
#pragma unroll
                    for (int u = 0; u < 4; ++u) o[u] = *(const LAS f32x4*)(O32 + rto * HOS + g8o * 16 + u * 4);
                    if (d == 0) {
                        GAS v4u* ofp = (GAS v4u*)((GAS char*)(OF + h * 128) + ((unsigned)rrow * DM + g8o * 16) * 2u);
                        ofp[0] = (v4u){pk2(o[0].x, o[0].y), pk2(o[0].z, o[0].w), pk2(o[1].x, o[1].y), pk2(o[1].z, o[1].w)};
                        ofp[1] = (v4u){pk2(o[2].x, o[2].y), pk2(o[2].z, o[2].w), pk2(o[3].x, o[3].y), pk2(o[3].z, o[3].w)};
                    } else if (do_out) {
                        float ss = 0.f;
#pragma unroll
                        for (int u2 = 0; u2 < 2; ++u2) { const v4u f = pf[u2];
                            o[2 * u2] = o[2 * u2] + (f32x4){bflo(f.x), bfhi(f.x), bflo(f.y), bfhi(f.y)}; o[2 * u2 + 1] = o[2 * u2 + 1] + (f32x4){bflo(f.z), bfhi(f.z), bflo(f.w), bfhi(f.w)}; }
#pragma unroll
                        for (int u = 0; u < 4; ++u) ss += (o[u].x * o[u].x + o[u].y * o[u].y) + (o[u].z * o[u].z + o[u].w * o[u].w);
                        ss = sum8(ss);
                        const float r = __builtin_amdgcn_rsqf(ss * (1.f / 128.f) + RMS_EPS);
                        GAS v4u* gp = (GAS v4u*)((GAS char*)(P + 4 * DM + h * 128) + ((unsigned)rrow * HG_N + g8o * 16) * 2u);
#pragma unroll
                        for (int u2 = 0; u2 < 2; ++u2) { const v4u rg = pg[u2]; const f32x4 oa = o[2 * u2], ob2 = o[2 * u2 + 1]; const f32x4 nga = *(const LAS f32x4*)(s_ng + g8o * 16 + u2 * 8), ngb = *(const LAS f32x4*)(s_ng + g8o * 16 + u2 * 8 + 4); const float ngp[8] = {nga.x, nga.y, nga.z, nga.w, ngb.x, ngb.y, ngb.z, ngb.w};
                            const float y0 = oa.x * r * ngp[0] * bflo(rg.x), y1 = oa.y * r * ngp[1] * bfhi(rg.x), y2 = oa.z * r * ngp[2] * bflo(rg.y), y3 = oa.w * r * ngp[3] * bfhi(rg.y);
                            const float y4 = ob2.x * r * ngp[4] * bflo(rg.z), y5 = ob2.y * r * ngp[5] * bfhi(rg.z), y6 = ob2.z * r * ngp[6] * bflo(rg.w), y7 = ob2.w * r * ngp[7] * bfhi(rg.w);
                            gp[u2] = (v4u){pk2(y0, y1), pk2(y2, y3), pk2(y4, y5), pk2(y6, y7)}; }
                    }
                }
            }
            __threadfence(); __syncthreads();
        }
    }
}

constexpr int GS = 136, GT = 80, GB = 40;
constexpr int GD_KC = 0, GD_QC = 17408, GD_KCT = 34816, GD_VT = 55296, GD_SB = 75776, GD_O16 = 110592, GD_RAW = 75776, GD_TUB = 128000, GD_TWB = 133120, GD_QKB = 138240, GD_LB = 143360, GD_SC = 148480;
constexpr int GW_RAW = 0, GW_ROW = 69632, GW_TR = 102400, GWT = 72;
__device__ __forceinline__ void gdn_conv_sweep(Frame& F, int b, int hq) {
    gb P = (gb)(F.ws + WS_P); gb KT = (gb)(F.ws + WS_H); gcf cwt = F.in[I_GDNCW];
    LAS bf16* RAW = (LAS bf16*)(F.lds + GW_RAW); LAS bf16* ROW = (LAS bf16*)(F.lds + GW_ROW); LAS bf16* TR = (LAS bf16*)(F.lds + GW_TR);
    const int tid_ = F.tid;
    __syncthreads();
    v2f cwp[5];
    { const int p = tid_ & 255, c = 2 * p; const int ccol = (c < 128) ? (hq * 128 + c) : (c < 256) ? (DM + hq * 128 + (c - 128)) : (2 * DM + hq * 256 + (c - 256));
#pragma unroll
      for (int t = 0; t < 5; ++t) cwp[t] = *(GAS const v2f*)(cwt + t * (4 * DM) + ccol); }
    v4u rawp[9];
#define GW_PREFETCH(st_) do { const int s0_ = (st_) * 64; const bool isctx_ = s0_ < TCX; const int slen_ = isctx_ ? TCX : TL, plo_ = isctx_ ? s0_ : s0_ - TCX, rowbase_ = isctx_ ? b * TCX : ROWS_C + b * TL; \
        _Pragma("unroll") for (int n_ = 0; n_ < 9; ++n_) { const int idx_ = tid + NTHREADS * n_; const int rr_ = idx_ >> 6, pc_ = idx_ & 63; const int pp_ = plo_ - 2 + rr_; \
            const int col_ = (pc_ < 16) ? (hq * 128 + pc_ * 8) : (pc_ < 32) ? (DM + hq * 128 + (pc_ - 16) * 8) : (2 * DM + hq * 256 + (pc_ - 32) * 8); \
            rawp[n_] = (idx_ < 68 * 64 && pp_ >= 0 && pp_ < slen_) ? *(GAS const v4u*)(P + (size_t)(rowbase_ + pp_) * GDN_NP + col_) : (v4u){0u, 0u, 0u, 0u}; } } while (0)
    { int tid = tid_; asm volatile("" : "+v"(tid)); GW_PREFETCH(0); }
#pragma unroll 1
    for (int st = 0; st < (TCX + TL) / 64; ++st) {
        const int s0 = st * 64; const bool isctx = s0 < TCX; const int plo = isctx ? s0 : s0 - TCX, rowbase = isctx ? b * TCX : ROWS_C + b * TL;
        int tid = tid_; asm volatile("" : "+v"(tid));
        LDS_BARRIER();
#pragma unroll
        for (int n = 0; n < 9; ++n) { const int idx = tid + NTHREADS * n; if (idx < 68 * 64) *(LAS v4u*)(RAW + (idx >> 6) * 512 + (idx & 63) * 8) = rawp[n]; }
        if (st + 1 < (TCX + TL) / 64) GW_PREFETCH(st + 1);
        LDS_BARRIER();
        const int p = tid & 255, cls = __builtin_amdgcn_readfirstlane(p >> 6);
#pragma unroll 1
        for (int n = 0; n < 4; ++n) {
            const int g = (tid >> 8) + 2 * n;
            v2f w[12];
#pragma unroll
            for (int e = 0; e < 12; ++e) { const unsigned x = *(const LAS unsigned*)(RAW + (g * 8 + e) * 512 + 2 * p); w[e] = (v2f){bflo(x), bfhi(x)}; }
            v2f sv[8];
#pragma unroll
            for (int e = 0; e < 8; ++e) {
                v2f a = w[e] * cwp[0]; a = w[e + 1] * cwp[1] + a; a = w[e + 2] * cwp[2] + a; a = w[e + 3] * cwp[3] + a; a = w[e + 4] * cwp[4] + a;
                const v2f na = a * (-1.4426950408889634f);
                v2f ex; ex.x = __builtin_amdgcn_exp2f(na.x); ex.y = __builtin_amdgcn_exp2f(na.y);
                const v2f den = ex + 1.0f;
                v2f rc; rc.x = __builtin_amdgcn_rcpf(den.x); rc.y = __builtin_amdgcn_rcpf(den.y);
                sv[e] = a * rc;
            }
            if (cls < 2) {
#pragma unroll
                for (int e = 0; e < 8; ++e) *(LAS unsigned*)(ROW + (g * 8 + e) * 256 + 2 * p) = pk2(sv[e].x, sv[e].y);
            }
            if (cls >= 1) {
                LAS bf16* tr = TR + 2 * (p - 64) * GWT + g * 8;
                *(LAS v4u*)(tr) = (v4u){pk2(sv[0].x, sv[1].x), pk2(sv[2].x, sv[3].x), pk2(sv[4].x, sv[5].x), pk2(sv[6].x, sv[7].x)};
                *(LAS v4u*)(tr + GWT) = (v4u){pk2(sv[0].y, sv[1].y), pk2(sv[2].y, sv[3].y), pk2(sv[4].y, sv[5].y), pk2(sv[6].y, sv[7].y)};
            }
        }
        asm volatile("s_waitcnt vmcnt(0)" ::: "memory");
        LDS_BARRIER();
        const size_t grow = (size_t)(rowbase + plo);
#pragma unroll
        for (int n = 0; n < 4; ++n) { const int idx = tid + NTHREADS * n; const int rr = idx >> 5, pc = idx & 31;
            const int col = (pc < 16) ? (hq * 128 + pc * 8) : (DM + hq * 128 + (pc - 16) * 8);
            *(GAS v4u*)(P + (grow + rr) * GDN_NP + col) = *(const LAS v4u*)(ROW + rr * 256 + pc * 8); }
#pragma unroll
        for (int n = 0; n < 2; ++n) { const int idx = tid + NTHREADS * n; const int ch = idx >> 3, pc = idx & 7;
            *(GAS v4u*)(KT + ((grow >> 6) * 16 + hq) * 8192 + ch * 64 + pc * 8) = *(const LAS v4u*)(TR + ch * GWT + pc * 8); }
#pragma unroll
        for (int n = 0; n < 4; ++n) { const int idx = tid + NTHREADS * n; const int c = idx >> 3, pc = idx & 7, ch = c & 127;
            *(GAS v4u*)(P + (grow + (ch >> 1)) * GDN_NP + 2 * DM + hq * 256 + (c >> 7) * 128 + (ch & 1) * 64 + pc * 8) = *(const LAS v4u*)(TR + (128 + c) * GWT + pc * 8); }
    }
#undef GW_PREFETCH
    __threadfence(); __syncthreads();
}
template <int CTRL> __device__ __forceinline__ float dpp0(float x) { return __builtin_bit_cast(float, __builtin_amdgcn_update_dpp(0, __builtin_bit_cast(int, x), CTRL, 0xf, 0xf, true)); }
__device__ __forceinline__ void phase_gdn2(Frame& F, bool ctx_out, bool dry = false) {
    FRAME_TID(F);
    gb P = (gb)(F.ws + WS_P); gb OB = (gb)(F.ws + WS_O); gb KT = (gb)(F.ws + WS_H);
    gcf alog = F.in[I_GDNALOG]; gcf dtb = F.in[I_GDNDTB]; gcf ng = F.in[I_GDNNG];
    LAS bf16* KC = (LAS bf16*)(F.lds + GD_KC); LAS bf16* QC = (LAS bf16*)(F.lds + GD_QC); LAS bf16* KCT = (LAS bf16*)(F.lds + GD_KCT); LAS bf16* VT = (LAS bf16*)(F.lds + GD_VT);
    LAS bf16* O16 = (LAS bf16*)(F.lds + GD_O16);
    LAS bf16* TUB = (LAS bf16*)(F.lds + GD_TUB); LAS bf16* TWB = (LAS bf16*)(F.lds + GD_TWB); LAS bf16* QKB = (LAS bf16*)(F.lds + GD_QKB);
    LAS float* LB = (LAS float*)(F.lds + GD_LB); LAS float* s_ng = (LAS float*)(F.lds + 151552);
    LAS float* s_gate0 = (LAS float*)(F.lds + GD_SC);
    LAS float* s_ckd = s_gate0 + 416; LAS float* s_rq = s_ckd + 64; LAS float* s_rk = s_rq + 64;
    LAS bf16* W = KC;
    const int vb = F.wave;
    const int tid_ = F.tid, lane_ = F.lane;
    for (int item2 = blockIdx.x; item2 < NB * 16; item2 += F.G) {
      gdn_conv_sweep(F, item2 >> 4, item2 & 15);
      for (int ev = 0; ev < 2; ++ev) {
        const int item = item2 * 2 + ev;
        const int b = item >> 5, hv = item & 31, hq = hv >> 1;
        LDS_BARRIER();
        for (int i = tid_; i < 3 * 5120 / 16; i += NTHREADS) ((LAS v4u*)(F.lds + GD_TUB))[i] = (v4u){0u, 0u, 0u, 0u};
        if (tid_ < 128) s_ng[tid_] = ng[tid_];
        for (int i = tid_; i < 256 * 2; i += NTHREADS) { const int r = i >> 1, hh = i & 1; LAS bf16* img = (r < 128) ? KCT : VT; *(LAS v4u*)(img + (r & 127) * GT + 64 + hh * 8) = (v4u){0u, 0u, 0u, 0u}; }
        for (int d = 0; d < 2; ++d) {
            const float dtbv = dtb[d * 32 + hv], aexp = __expf(alog[d * 32 + hv]);
            f32x4 S[8];
#pragma unroll
            for (int kt = 0; kt < 8; ++kt) S[kt] = (f32x4){0.f, 0.f, 0.f, 0.f};
            v4u rawp[8]; unsigned short gpb_ = 0, gpa_ = 0;
#define GDN_PREFETCH(st_) do { const int s0_ = (st_) * 64; const bool isctx_ = s0_ < TCX; const int slen_ = isctx_ ? TCX : TL, sp0_ = isctx_ ? s0_ : s0_ - TCX; \
                const int plo_ = d ? (slen_ - 64 - sp0_) : sp0_, rowbase_ = isctx_ ? b * TCX : ROWS_C + b * TL; \
                {   \
                  GAS const char* ubq_ = (GAS const char*)(P + (size_t)(rowbase_ + plo_) * GDN_NP + hq * 128); \
                  const unsigned lo_ = ((unsigned)(tid >> 4) * GDN_NP + (tid & 15) * 8) * 2u, lo32_ = lo_ + 32u * GDN_NP * 2u; \
                  rawp[0] = *(GAS const v4u*)(ubq_ + lo_); rawp[1] = *(GAS const v4u*)(ubq_ + lo32_); rawp[2] = *(GAS const v4u*)(ubq_ + DM * 2 + lo_); rawp[3] = *(GAS const v4u*)(ubq_ + DM * 2 + lo32_); \
                  GAS const char* ubk_ = (GAS const char*)(KT + ((size_t)((rowbase_ + plo_) >> 6) * 16 + hq) * 8192); const unsigned lk_ = (unsigned)tid * 16u; \
                  rawp[4] = *(GAS const v4u*)(ubk_ + lk_); rawp[5] = *(GAS const v4u*)(ubk_ + 8192 + lk_); \
                  GAS const char* ubv_ = (GAS const char*)(P + (size_t)(rowbase_ + plo_) * GDN_NP + 2 * DM + hv * 128); \
                  rawp[6] = *(GAS const v4u*)(ubv_ + lo_); rawp[7] = *(GAS const v4u*)(ubv_ + lo32_); } \
                if (tid >= 448) { const int ti_ = tid - 448; const int pp_ = d ? (plo_ + 63 - ti_) : (plo_ + ti_); gcb pr_ = P + (size_t)(rowbase_ + pp_) * GDN_NP + 3 * 2 * DM + d * 64 + hv; \
                    gpb_ = pr_[0]; gpa_ = pr_[32]; } } while (0)
#define GDN_GATES(par_) do { LAS float* gb_ = s_gate0 + (par_) * 208; const int ti = tid - 448; \
                const float xb = bf2f(gpb_), xa = bf2f(gpa_) + dtbv; \
                const float sp = (xa > 20.f) ? xa : log1pf(__expf(xa)); \
                const float be = sigmoid_f(xb); float gg = -aexp * sp; \
                gg += dpp0<0x111>(gg); gg += dpp0<0x112>(gg); gg += dpp0<0x114>(gg); gg += dpp0<0x118>(gg);     \
                gb_[ti] = be; gb_[64 + ti] = gg; gb_[128 + ti] = __expf(gg); \
                if ((ti & 15) == 15) gb_[192 + (ti >> 4)] = __expf(gg); } while (0)
#define GDN_RD_LOAD(row_, f0_, f1_, z0_, z1_) do { GAS const char* ob_ = (GAS const char*)(OB + hv * 128); const unsigned oo_ = ((unsigned)(row_) * (2 * DM) + g8 * 16) * 2u; f0_ = *(GAS const v4u*)(ob_ + oo_); f1_ = *(GAS const v4u*)(ob_ + oo_ + 16); \
                GAS const char* zb_ = (GAS const char*)(P + 4 * DM + hv * 128); const unsigned zo_ = ((unsigned)(row_) * GDN_NP + g8 * 16) * 2u; z0_ = *(GAS const v4u*)(zb_ + zo_); z1_ = *(GAS const v4u*)(zb_ + zo_ + 16); } while (0)
#define GDN_RD_OUT(tk_, f0_, f1_, z0_, z1_) do { const int rt_ = (tk_), g8_ = lane & 7; const int rrow_ = rowbase + (d ? (plo + 63 - rt_) : (plo + rt_)); \
                const v4u o0 = *(const LAS v4u*)(O16 + rt_ * GS + g8_ * 16), o1 = *(const LAS v4u*)(O16 + rt_ * GS + g8_ * 16 + 8); \
                if (d == 0) { GAS v4u* op = (GAS v4u*)((GAS char*)(OB + hv * 128) + ((unsigned)rrow_ * (2 * DM) + g8_ * 16) * 2u); op[0] = o0; op[1] = o1; } \
                else if (do_out) { \
                    GAS v4u* zp = (GAS v4u*)((GAS char*)(P + 4 * DM + hv * 128) + ((unsigned)rrow_ * GDN_NP + g8_ * 16) * 2u); \
                    const v4u f0 = f0_, f1 = f1_; \
                    float o[16]; \
                    o[0] = bflo(o0.x) + bflo(f0.x); o[1] = bfhi(o0.x) + bfhi(f0.x); o[2] = bflo(o0.y) + bflo(f0.y); o[3] = bfhi(o0.y) + bfhi(f0.y); \
                    o[4] = bflo(o0.z) + bflo(f0.z); o[5] = bfhi(o0.z) + bfhi(f0.z); o[6] = bflo(o0.w) + bflo(f0.w); o[7] = bfhi(o0.w) + bfhi(f0.w); \
                    o[8] = bflo(o1.x) + bflo(f1.x); o[9] = bfhi(o1.x) + bfhi(f1.x); o[10] = bflo(o1.y) + bflo(f1.y); o[11] = bfhi(o1.y) + bfhi(f1.y); \
                    o[12] = bflo(o1.z) + bflo(f1.z); o[13] = bfhi(o1.z) + bfhi(f1.z); o[14] = bflo(o1.w) + bflo(f1.w); o[15] = bfhi(o1.w) + bfhi(f1.w); \
                    float ss = 0.f; \
                    _Pragma("unroll") for (int t = 0; t < 16; ++t) ss += o[t] * o[t]; \
                    ss = sum8(ss); \
                    const float r = __builtin_amdgcn_rsqf(ss * (1.f / 128.f) + RMS_EPS); \
                    _Pragma("unroll") for (int u2 = 0; u2 < 2; ++u2) { const v4u z = u2 ? z1_ : z0_; const f32x4 nga = *(const LAS f32x4*)(s_ng + g8_ * 16 + u2 * 8), ngb = *(const LAS f32x4*)(s_ng + g8_ * 16 + u2 * 8 + 4); const float ngp[8] = {nga.x, nga.y, nga.z, nga.w, ngb.x, ngb.y, ngb.z, ngb.w}; const float* oo = o + u2 * 8; \
                        const float y0 = oo[0] * r * ngp[0] * bflo(z.x), y1 = oo[1] * r * ngp[1] * bfhi(z.x), y2 = oo[2] * r * ngp[2] * bflo(z.y), y3 = oo[3] * r * ngp[3] * bfhi(z.y); \
                        const float y4 = oo[4] * r * ngp[4] * bflo(z.z), y5 = oo[5] * r * ngp[5] * bfhi(z.z), y6 = oo[6] * r * ngp[6] * bflo(z.w), y7 = oo[7] * r * ngp[7] * bfhi(z.w); \
                        zp[u2] = (v4u){pk2(y0, y1), pk2(y2, y3), pk2(y4, y5), pk2(y6, y7)}; } \
                } } while (0)
            { int tid = tid_; asm volatile("" : "+v"(tid)); GDN_PREFETCH(0); if (tid >= 448) GDN_GATES(0); }
#pragma unroll 1
            for (int st = 0; st < (TCX + TL) / 64; ++st) {
                const int s0 = st * 64; const bool isctx = s0 < TCX; const int slen = isctx ? TCX : TL, sp0 = isctx ? s0 : s0 - TCX;
                const int plo = d ? (slen - 64 - sp0) : sp0, rowbase = isctx ? b * TCX : ROWS_C + b * TL;
                int tid = tid_, lane = lane_; asm volatile("" : "+v"(tid), "+v"(lane));
                const int stp = st > 0 ? st - 1 : 0; const int s0p = stp * 64; const bool isctxp = s0p < TCX; const int slenp = isctxp ? TCX : TL, sp0p = isctxp ? s0p : s0p - TCX;
                const int plop = d ? (slenp - 64 - sp0p) : sp0p, rowbasep = isctxp ? b * TCX : ROWS_C + b * TL;
                const bool do_outp = (d == 1) && !dry && st > 0 && (ctx_out || !isctxp);
                const int tkA = (vb == 0) ? 0 : 8 * (vb - 1) + (lane >> 3);
                v4u pfA0, pfA1, pzA0, pzA1;
                { const int g8 = lane & 7; const int rowA = do_outp ? rowbasep + (plop + 63 - tkA) : 0; GDN_RD_LOAD(rowA, pfA0, pfA1, pzA0, pzA1); }
                const int l15 = lane & 15, q4 = lane >> 4;
                LAS float* s_beta = s_gate0 + (st & 1) * 208; LAS float* s_G = s_beta + 64; LAS float* s_eG = s_beta + 128; LAS float* s_eGend = s_beta + 192;
                {
                    const int r0 = tid >> 4, pc = (tid & 15) * 8;
                    const int t0 = d ? 63 - r0 : r0, t1 = d ? 31 - r0 : r0 + 32;
                    *(LAS v4u*)(QC + t0 * GS + pc) = rawp[0]; *(LAS v4u*)(QC + t1 * GS + pc) = rawp[1];
                    *(LAS v4u*)(KC + t0 * GS + pc) = rawp[2]; *(LAS v4u*)(KC + t1 * GS + pc) = rawp[3];
                    const int pcs = tid & 7, tp = d ? 56 - pcs * 8 : pcs * 8;
                    v4u x4 = rawp[4], x5 = rawp[5], x6 = rawp[6], x7 = rawp[7];
                    if (d) {
#define GDN_REV(x_) x_ = (v4u){__builtin_amdgcn_alignbit(x_.w, x_.w, 16), __builtin_amdgcn_alignbit(x_.z, x_.z, 16), __builtin_amdgcn_alignbit(x_.y, x_.y, 16), __builtin_amdgcn_alignbit(x_.x, x_.x, 16)}
                        GDN_REV(x4); GDN_REV(x5); GDN_REV(x6); GDN_REV(x7);
#undef GDN_REV
                    }
                    const int kch = tid >> 3;
                    *(LAS v4u*)(KCT + kch * GT + tp) = x4; *(LAS v4u*)(KCT + (kch + 64) * GT + tp) = x5;
                    const int vch = 2 * r0 + ((tid >> 3) & 1);
                    *(LAS v4u*)(VT + vch * GT + tp) = x6; *(LAS v4u*)(VT + (vch + 64) * GT + tp) = x7;
                }
                if (st + 1 < (TCX + TL) / 64) GDN_PREFETCH(st + 1);
                LDS_BARRIER();
                {
                    const int t = tid >> 3, which = (tid >> 2) & 1, part = tid & 3;
                    const LAS v4u* src = (const LAS v4u*)((which ? KC : QC) + t * GS + part * 32);
                    float ss = 0.f;
#pragma unroll
                    for (int u = 0; u < 4; ++u) { const v4u x = src[u]; const float f0 = bflo(x.x), f1 = bfhi(x.x), f2 = bflo(x.y), f3 = bfhi(x.y), f4 = bflo(x.z), f5 = bfhi(x.z), f6 = bflo(x.w), f7 = bfhi(x.w);
                        ss += (f0 * f0 + f1 * f1) + (f2 * f2 + f3 * f3) + (f4 * f4 + f5 * f5) + (f6 * f6 + f7 * f7); }
                    ss += dppf<0xB1>(ss); ss += dppf<0x4E>(ss);
                    if (part == 0) { const float r = __builtin_amdgcn_rsqf(ss + RMS_EPS); if (which) s_rk[t] = r; else s_rq[t] = r * 0.08838834764831845f; }
                }
                f32x4 blk = (f32x4){0.f, 0.f, 0.f, 0.f};
                const int bI = vb & 3;
                {
                    LAS bf16* bimg = (vb < 4) ? KC : QC;
#pragma unroll
                    for (int ks = 0; ks < 4; ++ks) { const hb8 fa = *(const LAS hb8*)(KC + (bI * 16 + l15) * GS + ks * 32 + q4 * 8), fb = *(const LAS hb8*)(bimg + (bI * 16 + l15) * GS + ks * 32 + q4 * 8);
                        blk = MFMA16(fa, fb, blk); }
                }
                LDS_BARRIER();
                {
                    const int t = bI * 16 + l15, sb0 = bI * 16 + q4 * 4;
                    const float Gt = s_G[t]; const f32x4 Gs = *(const LAS f32x4*)(s_G + sb0), rks = *(const LAS f32x4*)(s_rk + sb0);
                    if (vb < 4) {
                        const float rowf = s_beta[t] * s_rk[t];
                        f32x4 lv;
#pragma unroll
                        for (int i = 0; i < 4; ++i) lv[i] = (q4 * 4 + i < l15) ? rowf * rks[i] * blk[i] * __expf(Gt - Gs[i]) : 0.f;
                        *(LAS f32x4*)(LB + (bI * 16 + l15) * 20 + q4 * 4) = lv;
                    } else {
                        float qv[4];
#pragma unroll
                        for (int i = 0; i < 4; ++i) qv[i] = (q4 * 4 + i <= l15) ? rks[i] * blk[i] * __expf(Gt - Gs[i]) : 0.f;
                        *(LAS v2u*)(QKB + (bI * 16 + l15) * GB + q4 * 4) = (v2u){pk2(qv[0], qv[1]), pk2(qv[2], qv[3])};
                    }
                    if (tid >= 448) { const int ti = tid - 448; s_ckd[ti] = s_rk[ti] * __expf(s_G[(ti & 48) + 15] - s_G[ti]); }
                }
                LDS_BARRIER();
                if (vb == 7) {
                    const int plo = plop, rowbase = rowbasep; const bool do_out = do_outp;
                    v4u pfB0, pfB1, pzB0, pzB1;
                    { const int g8 = lane & 7; const int rowB = do_outp ? rowbasep + (plop + 63 - (tkA + 8)) : 0; GDN_RD_LOAD(rowB, pfB0, pfB1, pzB0, pzB1); }
                    if (st + 1 < (TCX + TL) / 64) GDN_GATES((st + 1) & 1);
                    if (st > 0) { GDN_RD_OUT(tkA, pfA0, pfA1, pzA0, pzA1); GDN_RD_OUT(tkA + 8, pfB0, pfB1, pzB0, pzB1); }
                } else if (vb != 0) {
                    const int plo = plop, rowbase = rowbasep; const bool do_out = do_outp;
                    if (st > 0) GDN_RD_OUT(tkA, pfA0, pfA1, pzA0, pzA1);
                }
                if (vb == 0) {
                    __builtin_amdgcn_s_setprio(3);
                    const int I = lane >> 4, jc = lane & 15;
                    const LAS float* Lr = LB + (I * 16) * 20;
                    f32x4 la[8][2], lb[7][4];
#pragma unroll
                    for (int t = 1; t <= 8; ++t) { la[t - 1][0] = *(const LAS f32x4*)(Lr + t * 20); if (t > 4) la[t - 1][1] = *(const LAS f32x4*)(Lr + t * 20 + 4); }
                    asm volatile("" ::: "memory");
#pragma unroll
                    for (int t = 9; t <= 15; ++t) { lb[t - 9][0] = *(const LAS f32x4*)(Lr + t * 20); lb[t - 9][1] = *(const LAS f32x4*)(Lr + t * 20 + 4); lb[t - 9][2] = *(const LAS f32x4*)(Lr + t * 20 + 8); if (t > 12) lb[t - 9][3] = *(const LAS f32x4*)(Lr + t * 20 + 12); }
                    f32x4 T4[4];
#pragma unroll
                    for (int k = 0; k < 4; ++k) T4[k] = (f32x4){0.f, 0.f, 0.f, 0.f};
                    T4[0][0] = (jc == 0) ? 1.f : 0.f;
#pragma unroll
                    for (int t = 1; t <= 15; ++t) {
                        f32x4 acc = (t <= 8) ? la[t - 1][0] * T4[0] : lb[t - 9][0] * T4[0];
                        if (t > 4) acc = acc + ((t <= 8) ? la[t - 1][1] * T4[1] : lb[t - 9][1] * T4[1]);
                        if (t > 8) acc = acc + lb[t > 8 ? t - 9 : 0][2] * T4[2];
                        if (t > 12) acc = acc + lb[t > 8 ? t - 9 : 0][3] * T4[3];
                        const float a = ((t == jc) ? 1.f : 0.f) - ((acc.x + acc.y) + (acc.z + acc.w));
                        T4[t >> 2][t & 3] = a;
                    }
                    const int sj = I * 16 + jc; const float cu = s_beta[sj], cwv = cu * s_rk[sj] * s_eG[sj];
#pragma unroll
                    for (int t = 0; t < 16; ++t) { const float tv = T4[t >> 2][t & 3]; TUB[(I * 16 + t) * GB + jc] = (bf16)f2bf(tv * cu); TWB[(I * 16 + t) * GB + jc] = (bf16)f2bf(tv * cwv); }
                    __builtin_amdgcn_s_setprio(0);
                }
                LDS_BARRIER();
                f32x4 U[4];
#pragma unroll
                for (int I = 0; I < 4; ++I) {
                    const hb8 fa = *(const LAS hb8*)(TUB + (I * 16 + l15) * GB + q4 * 8), fb = *(const LAS hb8*)(VT + (vb * 16 + l15) * GT + I * 16 + q4 * 8);
                    U[I] = MFMA16(fa, fb, ((f32x4){0.f, 0.f, 0.f, 0.f}));
                    const hb8 ga = *(const LAS hb8*)(KCT + (vb * 16 + l15) * GT + I * 16 + q4 * 8), gbv = *(const LAS hb8*)(TWB + (I * 16 + l15) * GB + q4 * 8);
                    const f32x4 wt = MFMA16(ga, gbv, ((f32x4){0.f, 0.f, 0.f, 0.f}));
                    *(LAS v2u*)(W + (I * 16 + l15) * GS + vb * 16 + q4 * 4) = (v2u){pk2(-wt.x, -wt.y), pk2(-wt.z, -wt.w)};
                }
                LDS_WAIT(); asm volatile("" ::: "memory");
                LDS_BARRIER();
#pragma unroll
                for (int I = 0; I < 4; ++I) {
                    f32x4 vn = U[I], oa = (f32x4){0.f, 0.f, 0.f, 0.f};
#pragma unroll
                    for (int ks = 0; ks < 4; ++ks) {
                        const v4u sb4 = (v4u){pk2(S[2 * ks].x, S[2 * ks].y), pk2(S[2 * ks].z, S[2 * ks].w), pk2(S[2 * ks + 1].x, S[2 * ks + 1].y), pk2(S[2 * ks + 1].z, S[2 * ks + 1].w)};
                        const hb8 fb = __builtin_bit_cast(hb8, sb4);
                        const v2u w0 = *(const LAS v2u*)(W + (I * 16 + l15) * GS + ks * 32 + q4 * 4), w1 = *(const LAS v2u*)(W + (I * 16 + l15) * GS + ks * 32 + 16 + q4 * 4);
                        const v2u q0 = *(const LAS v2u*)(QC + (I * 16 + l15) * GS + ks * 32 + q4 * 4), q1 = *(const LAS v2u*)(QC + (I * 16 + l15) * GS + ks * 32 + 16 + q4 * 4);
                        const v4u fw4 = (v4u){w0.x, w0.y, w1.x, w1.y}, fq4 = (v4u){q0.x, q0.y, q1.x, q1.y};
                        vn = MFMA16(__builtin_bit_cast(hb8, fw4), fb, vn); oa = MFMA16(__builtin_bit_cast(hb8, fq4), fb, oa); }
                    const f32x4 ck = *(const LAS f32x4*)(s_ckd + I * 16 + q4 * 4), eg = *(const LAS f32x4*)(s_eG + I * 16 + q4 * 4), rqv = *(const LAS f32x4*)(s_rq + I * 16 + q4 * 4);
                    const v4u vn4 = (v4u){pk2(vn.x, vn.y), pk2(vn.z, vn.w), 0u, 0u}, vp4 = (v4u){pk2(vn.x * ck.x, vn.y * ck.y), pk2(vn.z * ck.z, vn.w * ck.w), 0u, 0u};
                    oa = oa * eg;
                    { const v2u a0 = *(const LAS v2u*)(QKB + (I * 16 + l15) * GB + q4 * 4); const v4u fa4 = (v4u){a0.x, a0.y, 0u, 0u}; oa = MFMA16(__builtin_bit_cast(hb8, fa4), __builtin_bit_cast(hb8, vn4), oa); }
                    oa = oa * rqv;
#pragma unroll
                    for (int i = 0; i < 4; ++i) O16[(I * 16 + q4 * 4 + i) * GS + vb * 16 + l15] = (bf16)f2bf(oa[i]);
                    const float ege = s_eGend[I];
                    const hb8 fbn = __builtin_bit_cast(hb8, vp4);
#pragma unroll
                    for (int kt = 0; kt < 8; ++kt) { const v2u a0 = *(const LAS v2u*)(KCT + (kt * 16 + l15) * GT + I * 16 + q4 * 4); const v4u fa4 = (v4u){a0.x, a0.y, 0u, 0u}; S[kt] = MFMA16(__builtin_bit_cast(hb8, fa4), fbn, S[kt] * ege); }
                }
                LDS_BARRIER();
            }
            if (vb != 0) {
                const int st = (TCX + TL) / 64 - 1; const int s0 = st * 64; const int sp0 = s0 - TCX;
                const int plo = d ? (TL - 64 - sp0) : sp0, rowbase = ROWS_C + b * TL;
                int lane = lane_; asm volatile("" : "+v"(lane));
                const bool do_out = (d == 1) && !dry;
                const int tkA = 8 * (vb - 1) + (lane >> 3), g8 = lane & 7;
                v4u pfA0, pfA1, pzA0, pzA1;
                GDN_RD_LOAD(do_out ? rowbase + (plo + 63 - tkA) : 0, pfA0, pfA1, pzA0, pzA1);
                GDN_RD_OUT(tkA, pfA0, pfA1, pzA0, pzA1);
                if (vb == 7) { v4u pfB0, pfB1, pzB0, pzB1; GDN_RD_LOAD(do_out ? rowbase + (plo + 63 - (tkA + 8)) : 0, pfB0, pfB1, pzB0, pzB1); GDN_RD_OUT(tkA + 8, pfB0, pfB1, pzB0, pzB1); }
            }
#undef GDN_PREFETCH
#undef GDN_GATES
#undef GDN_RD_LOAD
#undef GDN_RD_OUT
            __threadfence(); __syncthreads();
        }
      }
    }
}

constexpr int NKS = 40, NVS = 1032;
constexpr int NA_KI = 0, NA_VTI = 81920, NA_BIAS = 147968;
__device__ __forceinline__ float xq_max(float x) {
    auto s = __builtin_amdgcn_permlane16_swap(__float_as_uint(x), __float_as_uint(x), false, false); x = fmaxf(__uint_as_float(s[0]), __uint_as_float(s[1]));
    auto t = __builtin_amdgcn_permlane32_swap(__float_as_uint(x), __float_as_uint(x), false, false); return fmaxf(__uint_as_float(t[0]), __uint_as_float(t[1])); }
__device__ __forceinline__ float xq_sum(float x) {
    auto s = __builtin_amdgcn_permlane16_swap(__float_as_uint(x), __float_as_uint(x), false, false); x = __uint_as_float(s[0]) + __uint_as_float(s[1]);
    auto t = __builtin_amdgcn_permlane32_swap(__float_as_uint(x), __float_as_uint(x), false, false); return __uint_as_float(t[0]) + __uint_as_float(t[1]); }
#define NA_LOAD(count_, GROW_EXPR) do { const int kk = tid >> 1, role = tid & 1; if (kk < (count_)) { const size_t grow = (size_t)(GROW_EXPR); \
        GAS const v4u* src = (GAS const v4u*)(P + grow * NA_N + (role ? 2 * DM : DM) + h * 32); \
        _Pragma("unroll") for (int t_ = 0; t_ < 4; ++t_) x[t_] = src[t_]; } } while (0)
#define NA_STORE(count_, SLOT_EXPR) do { const int kk = tid >> 1, role = tid & 1; if (kk < (count_)) { const int slot = (SLOT_EXPR); \
        if (role == 0) { float kf[32]; float ss = 0.f; \
            _Pragma("unroll") for (int t_ = 0; t_ < 4; ++t_) { kf[8 * t_ + 0] = bflo(x[t_].x); kf[8 * t_ + 1] = bfhi(x[t_].x); kf[8 * t_ + 2] = bflo(x[t_].y); kf[8 * t_ + 3] = bfhi(x[t_].y); \
                kf[8 * t_ + 4] = bflo(x[t_].z); kf[8 * t_ + 5] = bfhi(x[t_].z); kf[8 * t_ + 6] = bflo(x[t_].w); kf[8 * t_ + 7] = bfhi(x[t_].w); } \
            _Pragma("unroll") for (int t_ = 0; t_ < 32; ++t_) ss += kf[t_] * kf[t_]; \
            const float rn = __builtin_amdgcn_rsqf(ss * (1.f / 32.f) + RMS_EPS); \
            _Pragma("unroll") for (int t_ = 0; t_ < 4; ++t_) *(LAS v4u*)(KI + slot * NKS + 8 * t_) = (v4u){pk2(kf[8 * t_] * rn * kg[8 * t_], kf[8 * t_ + 1] * rn * kg[8 * t_ + 1]), pk2(kf[8 * t_ + 2] * rn * kg[8 * t_ + 2], kf[8 * t_ + 3] * rn * kg[8 * t_ + 3]), \
                pk2(kf[8 * t_ + 4] * rn * kg[8 * t_ + 4], kf[8 * t_ + 5] * rn * kg[8 * t_ + 5]), pk2(kf[8 * t_ + 6] * rn * kg[8 * t_ + 6], kf[8 * t_ + 7] * rn * kg[8 * t_ + 7])}; \
        } else { \
            _Pragma("unroll") for (int t_ = 0; t_ < 4; ++t_) { VTI[(8 * t_ + 0) * NVS + slot] = (bf16)(x[t_].x & 0xffffu); VTI[(8 * t_ + 1) * NVS + slot] = (bf16)(x[t_].x >> 16); VTI[(8 * t_ + 2) * NVS + slot] = (bf16)(x[t_].y & 0xffffu); VTI[(8 * t_ + 3) * NVS + slot] = (bf16)(x[t_].y >> 16); \
                VTI[(8 * t_ + 4) * NVS + slot] = (bf16)(x[t_].z & 0xffffu); VTI[(8 * t_ + 5) * NVS + slot] = (bf16)(x[t_].z >> 16); VTI[(8 * t_ + 6) * NVS + slot] = (bf16)(x[t_].w & 0xffffu); VTI[(8 * t_ + 7) * NVS + slot] = (bf16)(x[t_].w >> 16); } \
        } } } while (0)

__device__ __forceinline__ void na_qblock(gcb P, gb Oo, LAS bf16* KI, LAS bf16* VTI, LAS float* bias, const LAS float* qg, int h, int qrow0, bool lat, int r, int cb, int lane, bool dry, v4u qraw, unsigned (&tbl)[32], int& tbl_d) {
    const int l15 = lane & 15, q4 = lane >> 4;
    hb8 qf;
    {
        const v4u x = qraw;
        float f[8] = {bflo(x.x), bfhi(x.x), bflo(x.y), bfhi(x.y), bflo(x.z), bfhi(x.z), bflo(x.w), bfhi(x.w)};
        float ss = 0.f;
#pragma unroll
        for (int t = 0; t < 8; ++t) ss += f[t] * f[t];
        ss = xq_sum(ss);
        const float rn = __builtin_amdgcn_rsqf(ss * (1.f / 32.f) + RMS_EPS) * (0.17677669529663687f * 1.4426950408889634f);
        { const f32x4 g0 = *(const LAS f32x4*)(qg + q4 * 8), g1 = *(const LAS f32x4*)(qg + q4 * 8 + 4); const float gq[8] = {g0.x, g0.y, g0.z, g0.w, g1.x, g1.y, g1.z, g1.w};
#pragma unroll
        for (int t = 0; t < 8; ++t) f[t] = f[t] * rn * gq[t]; }
        const v4u pk = (v4u){pk2(f[0], f[1]), pk2(f[2], f[3]), pk2(f[4], f[5]), pk2(f[6], f[7])};
        qf = __builtin_bit_cast(hb8, pk);
    }
    int r0 = r - 4; r0 = r0 < 0 ? 0 : (r0 > 24 ? 24 : r0);
    int kc0 = 16 * cb - 8; kc0 = kc0 < 0 ? 0 : (kc0 > 32 ? 32 : kc0);
    const int qcol = 16 * cb + l15;
    int c0 = qcol - 8; c0 = c0 < 0 ? 0 : (c0 > 48 ? 48 : c0);
    if (lat && (r - r0) != tbl_d) {
        tbl_d = r - r0;
#pragma unroll
        for (int ch = 0; ch < 2; ++ch)
#pragma unroll
            for (int tl = 0; tl < 8; ++tl) {
                const int kcol0 = kc0 + 16 * (tl & 1) + 4 * q4;
                const LAS float* bp = bias + (4 * ch + (tl >> 1) - tbl_d + 7) * 31;
                float tv[4];
#pragma unroll
                for (int i = 0; i < 4; ++i) { const int kcol = kcol0 + i; const bool ok = (kcol >= c0) && (kcol < c0 + 16);
                    int dc = kcol - qcol + 15; dc = dc < 0 ? 0 : (dc > 30 ? 30 : dc);
                    tv[i] = ok ? bp[dc] * 1.4426950408889634f : -INFINITY; }
                tbl[ch * 16 + tl * 2 + 0] = pk2(tv[0], tv[1]); tbl[ch * 16 + tl * 2 + 1] = pk2(tv[2], tv[3]);
            }
    }
    float mrun = -INFINITY, lrun = 0.f;
    f32x4 Oa[2] = {(f32x4){0.f, 0.f, 0.f, 0.f}, (f32x4){0.f, 0.f, 0.f, 0.f}};
#define NA_CHUNK(CH, LAT) do { \
        f32x4 sc[8]; int kbase[8]; \
        _Pragma("unroll") for (int tl = 0; tl < 8; ++tl) { \
            const int krow = r0 + 4 * (CH) + (tl >> 1); \
            kbase[tl] = (LAT) ? ((krow % 12) * 64 + kc0 + 16 * (tl & 1)) : (768 + ((CH) - 2) * 128 + tl * 16); \
            const hb8 fa = *(const LAS hb8*)(KI + (kbase[tl] + l15) * NKS + q4 * 8); \
            sc[tl] = MFMA16(fa, qf, ((f32x4){0.f, 0.f, 0.f, 0.f})); } \
        float mx = -INFINITY; \
        if (LAT) { \
            _Pragma("unroll") for (int tl = 0; tl < 8; ++tl) { \
                _Pragma("unroll") for (int i = 0; i < 4; ++i) { const unsigned tw = tbl[((LAT) ? (CH) : 0) * 16 + tl * 2 + (i >> 1)]; const float s_ = sc[tl][i] + ((i & 1) ? bfhi(tw) : bflo(tw)); sc[tl][i] = s_; mx = fmaxf(mx, s_); } } \
        } else { \
            _Pragma("unroll") for (int tl = 0; tl < 8; ++tl) mx = fmaxf(mx, fmaxf(fmaxf(sc[tl].x, sc[tl].y), fmaxf(sc[tl].z, sc[tl].w))); } \
        mx = xq_max(mx); \
        const float mnew = fmaxf(mrun, mx), corr = __builtin_amdgcn_exp2f(mrun - mnew); \
        lrun *= corr; Oa[0] = Oa[0] * corr; Oa[1] = Oa[1] * corr; mrun = mnew; \
        _Pragma("unroll") for (int ks = 0; ks < 4; ++ks) { \
            f32x4 p0, p1; \
            _Pragma("unroll") for (int i = 0; i < 4; ++i) { p0[i] = __builtin_amdgcn_exp2f(sc[2 * ks][i] - mnew); p1[i] = __builtin_amdgcn_exp2f(sc[2 * ks + 1][i] - mnew); } \
            lrun += (p0.x + p0.y) + (p0.z + p0.w) + (p1.x + p1.y) + (p1.z + p1.w); \
            const v4u pk = (v4u){pk2(p0.x, p0.y), pk2(p0.z, p0.w), pk2(p1.x, p1.y), pk2(p1.z, p1.w)}; \
            const hb8 fb = __builtin_bit_cast(hb8, pk); \
            _Pragma("unroll") for (int dt = 0; dt < 2; ++dt) { \
                const v2u a0 = *(const LAS v2u*)(VTI + (dt * 16 + l15) * NVS + kbase[2 * ks] + 4 * q4), a1 = *(const LAS v2u*)(VTI + (dt * 16 + l15) * NVS + kbase[2 * ks + 1] + 4 * q4); \
                const v4u av = (v4u){a0.x, a0.y, a1.x, a1.y}; \
                Oa[dt] = MFMA16(__builtin_bit_cast(hb8, av), fb, Oa[dt]); } } } while (0)
    if (lat) { NA_CHUNK(0, true); asm volatile("" ::: "memory"); NA_CHUNK(1, true); asm volatile("" ::: "memory"); }
#pragma unroll 1
    for (int ch = 2; ch < 4; ++ch) NA_CHUNK(ch, false);
#undef NA_CHUNK
    const float inv = 1.f / xq_sum(lrun);
    { const f32x4 o0 = Oa[0] * inv, o1 = Oa[1] * inv;
      const unsigned a0 = pk2(o0.x, o0.y), a1 = pk2(o0.z, o0.w), b0 = pk2(o1.x, o1.y), b1 = pk2(o1.z, o1.w);
      auto s0 = __builtin_amdgcn_permlane16_swap(a0, b0, false, false); auto s1 = __builtin_amdgcn_permlane16_swap(a1, b1, false, false);
      const int col = (q4 & 1) ? 16 + 4 * (q4 - 1) : 4 * q4;
      if (!dry) *(GAS v4u*)(Oo + (size_t)(qrow0 + l15) * DM + h * 32 + col) = (v4u){s0[0], s1[0], s0[1], s1[1]}; }
}

__device__ __forceinline__ void phase_na2(Frame& F, bool ctx_out, bool dry = false) {
    FRAME_TID(F);
    gcb P = (gcb)(F.ws + WS_P); gb Oo = (gb)(F.ws + WS_O);
    gcf qgg = F.in[I_NAQG], kg = F.in[I_NAKG], rpb = F.in[I_NARPB];
    LAS float* qg = (LAS float*)(F.lds + 150016);
    LAS bf16* KI = (LAS bf16*)(F.lds + NA_KI); LAS bf16* VTI = (LAS bf16*)(F.lds + NA_VTI); LAS float* bias = (LAS float*)(F.lds + NA_BIAS);
    const int tid_ = F.tid, lane_ = F.lane, wave = F.wave;
#define NA_QLOAD(qrow0_) (*(GAS const v4u*)(P + (size_t)((qrow0_) + (lane & 15)) * NA_N + h * 32 + (lane >> 4) * 8))
    for (int item = blockIdx.x; item < NB * 64; item += F.G) {
        const int b = item >> 6, h = item & 63;
        int tid = tid_, lane = lane_; asm volatile("" : "+v"(tid), "+v"(lane));
        v4u x[4];
        unsigned tbl[32]; int tbl_d = -100;
        LDS_BARRIER();
        for (int idx = tid; idx < 15 * 31; idx += NTHREADS) bias[idx] = rpb[h * 465 + idx];
        if (tid < 32) qg[tid] = qgg[tid];
        NA_LOAD(256, b * TCX + kk); NA_STORE(256, 768 + kk);
        NA_LOAD(256, ROWS_C + b * TL + kk); NA_STORE(256, kk);
        NA_LOAD(256, ROWS_C + b * TL + 256 + kk);
        LDS_BARRIER();
        if (ctx_out) {
            v4u qn = NA_QLOAD(b * TCX + wave * 16);
#pragma unroll 1
            for (int qb = wave; qb < 16; qb += 8) { const v4u qc = qn; if (qb + 8 < 16) qn = NA_QLOAD(b * TCX + (qb + 8) * 16);
                na_qblock(P, Oo, KI, VTI, bias, qg, h, b * TCX + qb * 16, false, 0, 0, lane, dry, qc, tbl, tbl_d); }
        }
        v4u qn = NA_QLOAD(ROWS_C + b * TL + (wave >> 2) * 64 + (wave & 3) * 16);
        NA_STORE(256, 256 + kk);
        int staged_hi = 7;
#pragma unroll 1
        for (int rg = 0; rg < 8; ++rg) {
            int nhi = 4 * (rg + 1) - 1; nhi = nhi > 24 ? 24 : nhi; nhi += 7;
            const int r1 = staged_hi + 1, ncnt = (rg < 7) ? (nhi - staged_hi) * 64 : 0;
            NA_LOAD(ncnt, ROWS_C + b * TL + r1 * 64 + kk);
            LDS_BARRIER();
            {
#pragma unroll 1
                for (int qb = wave; qb < 16; qb += 8) { const int r = rg * 4 + (qb >> 2), cb = qb & 3; const v4u qc = qn;
                    { const bool more = qb + 8 < 16; const int rgn = more ? rg : rg + 1, qbn = more ? qb + 8 : wave;
                      if (more || rg < 7) qn = NA_QLOAD(ROWS_C + b * TL + (rgn * 4 + (qbn >> 2)) * 64 + (qbn & 3) * 16); }
                    na_qblock(P, Oo, KI, VTI, bias, qg, h, ROWS_C + b * TL + r * 64 + cb * 16, true, r, cb, lane, dry, qc, tbl, tbl_d); }
            }
            LDS_BARRIER();
            NA_STORE(ncnt, ((r1 + (kk >> 6)) % 12) * 64 + (kk & 63));
            staged_hi = (rg < 7) ? nhi : staged_hi;
        }
    }
#undef NA_QLOAD
}

constexpr int NPH = 1 + 8 * DEPTH;
#define IN(k) (lo <= (k) && (k) < hi)
#define SEAM(k) do { if (IN(k) && IN((k) + 1)) { FRAME_TID(F); xcd_barrier(bar, F.tid); if (PROBE_BAR) xcd_barrier(bar, F.tid); } } while (0)
template <int L> __device__ __forceinline__ void layer_body(Frame& F, const Args& args, unsigned char* const wsg, const int lo, const int hi, const XcdBarrier& bar) {
        const int base = 1 + 8 * L, m = L % 3, j = L / 3;
        constexpr bool last = (L == DEPTH - 1);
        gcf modL = (gcf)(F.ws + WS_MOD) + (size_t)L * 17 * NMODC;
        _Float16* const X16A = (_Float16*)args.out; _Float16* const X16B = (_Float16*)(wsg + WS_O);
        _Float16* const X16mid = last ? X16B : X16A;
        const int NinP = (m == 0) ? HG_N : (m == 1) ? GDN_NP : NA_N;
        const int row_lo2 = last ? ROWS_C : 0;
        const int pm02 = row_lo2 / 256;

        if (IN(base + 0)) {
#if PROBE_THIN == 2
            phase_norm<(L != 0)>(F, F.in[I_NMG] + L * DM, modL, 0, F.in[I_X], F.in[I_CTX], (GAS const _Float16*)X16A, 0, M_ALL);
            __syncthreads();
#endif
#if PROBE_THIN == 3
            phase_wprep(F, L);
            __syncthreads();
#endif
            phase_wprep(F, L);
            phase_norm<(L != 0)>(F, F.in[I_NMG] + L * DM, modL, 0, F.in[I_X], F.in[I_CTX], (GAS const _Float16*)X16A, 0, M_ALL);
            SEAM(base + 0);
        }
        if (IN(base + 1)) {
            pg8::Gemm g{(const pg8::bf16_t*)(wsg + WS_H), (const pg8::bf16_t*)(wsg + WS_WT_IN), M_ALL, NinP, DM, DM};
            pg8::StaticOrder S; S.init(M_ALL, NinP, F.G, (int)blockIdx.x);
            pg8::EpiStore E{(pg8::bf16_t*)(wsg + WS_P), NinP, (m == 0) ? 0 : 0, (m == 0) ? 8 : 0, (m == 2) ? 0 : 32, (m == 0) ? 40 : (m == 1) ? 48 : 0};
            pg8::gemm_phase<pg8::EpiStore, pg8::StaticOrder, false, true>(F.lds, g, S, E, F.wave);
#if PROBE_GEMM == 8
            { __syncthreads(); pg8::EpiNull E0{(pg8::bf16_t*)(wsg + WS_O)}; pg8::ZeroOrder Z; Z.init(M_ALL, NinP, F.G, (int)blockIdx.x); pg8::gemm_phase<pg8::EpiNull, pg8::ZeroOrder, true, true>(F.lds, g, Z, E0, F.wave); }
#endif
#if PROBE_GEMM == 9
            { __syncthreads(); pg8::EpiNull E0{(pg8::bf16_t*)(wsg + WS_O)}; pg8::gemm_phase<pg8::EpiNull, pg8::StaticOrder, true, true>(F.lds, g, S, E0, F.wave); }
#endif
#if PROBE_GEMM == 1
            __syncthreads(); pg8::gemm_phase<pg8::EpiStore, pg8::StaticOrder, true, true>(F.lds, g, S, E, F.wave);
#endif
#if PROBE_GEMM == 5
            { __syncthreads(); pg8::EpiNull E0{(pg8::bf16_t*)(wsg + WS_O)}; pg8::gemm_phase<pg8::EpiNull, pg8::StaticOrder, true, true>(F.lds, g, S, E0, F.wave); }
#endif
            SEAM(base + 1);
        }
        if (IN(base + 2)) {
#if PROBE_MIX == 1
            if (m == 0) { phase_hg2(F, j, !last, args.ph_lo == 0); __syncthreads(); }
#endif
#if PROBE_MIX == 2
            if (m == 1) { phase_gdn2(F, !last, args.ph_lo == 0); __syncthreads(); }
#endif
#if PROBE_MIX == 3
            if (m == 2) { phase_na2(F, !last, args.ph_lo == 0); __syncthreads(); }
#endif
            if (m == 0) phase_hg2(F, j, !last);
            else if (m == 1) phase_gdn2(F, !last);
            else phase_na2(F, !last);
            SEAM(base + 2);
        }
        if (IN(base + 3)) {
            const pg8::bf16_t* A = (m == 2) ? (const pg8::bf16_t*)(wsg + WS_O) : (const pg8::bf16_t*)(wsg + WS_P) + 4 * DM;
            const int lda = (m == 0) ? HG_N : (m == 1) ? GDN_NP : DM, Kout = (m == 1) ? 2 * DM : DM;
            const int Mr = M_ALL - row_lo2;
            pg8::Gemm g{A + (size_t)row_lo2 * lda, (const pg8::bf16_t*)(wsg + WS_WT_OUT), Mr, DM, Kout, lda};
            pg8::StaticOrder S; S.init(Mr, DM, F.G, (int)blockIdx.x);
            typedef pg8::EpiResidT<(L != 0), true> EpiO;
            EpiO E{(const float*)args.in[I_X], (const float*)args.in[I_CTX], X16A, X16mid, nullptr, (const float*)modL + 2 * DM, pm02, 0};
            pg8::gemm_phase<EpiO, pg8::StaticOrder, true, true>(F.lds, g, S, E, F.wave);
            SEAM(base + 3);
        }
        if (IN(base + 4)) {
#if PROBE_THIN == 2
            phase_norm<true>(F, F.in[I_NFG] + L * DM, modL, 3, F.in[I_X], F.in[I_CTX], (GAS const _Float16*)X16mid, row_lo2, M_ALL);
#endif
            phase_norm<true>(F, F.in[I_NFG] + L * DM, modL, 3, F.in[I_X], F.in[I_CTX], (GAS const _Float16*)X16mid, row_lo2, M_ALL);
            SEAM(base + 4);
        }
        if (IN(base + 5)) {
            const int Mr = M_ALL - row_lo2;
            pg8::Gemm g{(const pg8::bf16_t*)(wsg + WS_H) + (size_t)row_lo2 * DM, (const pg8::bf16_t*)(wsg + WS_WT_UP), Mr, UP_N, DM, DM};
            pg8::StaticOrder S; S.init(Mr, UP_N, F.G, (int)blockIdx.x);
            pg8::EpiConvGate E{(pg8::bf16_t*)(wsg + WS_P) + (size_t)row_lo2 * DFF, (pg8::bf16_t*)(wsg + WS_WT_IN), args.in[I_FFNCW] + (size_t)L * 3 * UP_N, pm02};
            pg8::gemm_phase<pg8::EpiConvGate, pg8::StaticOrder, true, true>(F.lds, g, S, E, F.wave);
#if PROBE_GEMM == 2
            __syncthreads(); pg8::gemm_phase<pg8::EpiConvGate, pg8::StaticOrder, true, true>(F.lds, g, S, E, F.wave);
#endif
            SEAM(base + 5);
        }
        if (IN(base + 6)) {
            phase_ffnfix(F, L, row_lo2, M_ALL);
            SEAM(base + 6);
        }
        if (IN(base + 7)) {
            const int Mr = M_ALL - row_lo2;
            pg8::Gemm g{(const pg8::bf16_t*)(wsg + WS_P) + (size_t)row_lo2 * DFF, (const pg8::bf16_t*)(wsg + WS_WT_DN), Mr, DM, DFF, DFF};
            pg8::StaticOrder S; S.init(Mr, DM, F.G, (int)blockIdx.x);
            typedef pg8::EpiResidT<true, !last> EpiD;
            EpiD E{nullptr, nullptr, X16mid, X16A, args.out, (const float*)(wsg + WS_MOD) + (size_t)L * 17 * NMODC + 5 * DM, pm02, 0};
            pg8::gemm_phase<EpiD, pg8::StaticOrder, true, true>(F.lds, g, S, E, F.wave);
            SEAM(base + 7);
        }
    }
#undef IN
#undef SEAM
__global__ void __launch_bounds__(NTHREADS, 2) fwd(Args args) {
    extern __shared__ __attribute__((aligned(16))) unsigned char lds_raw[];
    Frame F;
    F.lds = (LAS unsigned char*)lds_raw;
    F.wave = __builtin_amdgcn_readfirstlane((int)threadIdx.x >> 6); FRAME_TID(F);
    F.G = gridDim.x; F.gw = blockIdx.x * NWAVES + F.wave; F.NGW = F.G * NWAVES;
#pragma unroll
    for (int i = 0; i < 26; ++i) F.in[i] = (gcf)args.in[i];
    F.out = (gf)args.out; F.ws = (GAS unsigned char*)args.ws;
    unsigned char* const wsg = args.ws;
    volatile LAS unsigned* MISC = (volatile LAS unsigned*)(F.lds + MISC_OFF);
    if (F.tid < 64) MISC[F.tid] = 0u;
    __syncthreads();
    const int lo = args.ph_lo, hi = args.ph_hi;
    XcdBarrier bar; bar.bar = (unsigned*)(wsg + WS_CTL) + CW_BAR; bar.x = 0; bar.st = MISC + 8;
    if (hi - lo > 1) bar = xcd_barrier_post((unsigned*)(wsg + WS_CTL) + CW_BAR, MISC + 8, F.tid);
#define IN(k) (lo <= (k) && (k) < hi)
#define SEAM(k) do { if (IN(k) && IN((k) + 1)) { FRAME_TID(F); xcd_barrier(bar, F.tid); if (PROBE_BAR) xcd_barrier(bar, F.tid); } } while (0)

#if PROBE_THIN == 4
    if (IN(0)) { phase_mod(F); __syncthreads(); }
#endif
    if (IN(0)) { phase_mod(F); SEAM(0); }

    layer_body<0>(F, args, wsg, lo, hi, bar);
    layer_body<1>(F, args, wsg, lo, hi, bar);
    layer_body<2>(F, args, wsg, lo, hi, bar);
    layer_body<3>(F, args, wsg, lo, hi, bar);
#undef IN
#undef SEAM
}

extern "C" void kernel_launch(void* const* d_in, const int* in_sizes, int n_in, void* d_out, int out_size, void* d_ws, size_t ws_size, hipStream_t stream) {
    static int grid = 0;
    if (grid == 0) {
        if (n_in != 26 || in_sizes[0] != ROWS_L * DM || out_size != ROWS_L * DM || ws_size < WS_END) {
            fprintf(stderr, "kernel_launch: unexpected shapes/workspace: n_in %d in0 %d out %d ws %zu (need %zu)\n", n_in, n_in > 0 ? in_sizes[0] : -1, out_size, ws_size, (size_t)WS_END); grid = -1; return; }
        int dev = 0, cus = 0;
        if (hipGetDevice(&dev) != hipSuccess || hipDeviceGetAttribute(&cus, hipDeviceAttributeMultiprocessorCount, dev) != hipSuccess) { grid = -1; return; }
        if (hipFuncSetAttribute((const void*)fwd, hipFuncAttributeMaxDynamicSharedMemorySize, LDS_BYTES) != hipSuccess) { fprintf(stderr, "kernel_launch: hipFuncSetAttribute failed\n"); grid = -1; return; }
        int per_cu = 0;
        if (hipOccupancyMaxActiveBlocksPerMultiprocessor(&per_cu, (const void*)fwd, NTHREADS, LDS_BYTES) != hipSuccess || per_cu < 1) fprintf(stderr, "kernel_launch: occupancy query reports %d\n", per_cu);
        (void)hipGetLastError();
        grid = cus;
    }
    if (grid < 0) return;
    if (hipMemsetAsync((char*)d_ws + WS_CTL, 0, CTL_ZERO_BYTES, stream) != hipSuccess) return;
    Args a{};
    for (int i = 0; i < 26; ++i) a.in[i] = (const float*)d_in[i];
    a.out = (float*)d_out; a.ws = (unsigned char*)d_ws;
#if MK_ONE_LAUNCH
    a.ph_lo = 0; a.ph_hi = NPH;
    hipLaunchKernelGGL(fwd, dim3(grid), dim3(NTHREADS), LDS_BYTES, stream, a);
#else
    for (int p = 0; p < NPH; ++p) { a.ph_lo = p; a.ph_hi = p + 1; hipLaunchKernelGGL(fwd, dim3(grid), dim3(NTHREADS), LDS_BYTES, stream, a); }
#endif
}
```
